# Optimizing an MI355X kernel written in HIP

```python
import jax, jax.numpy as jnp
from jax import lax
import numpy as np

D_MODEL = 2048
BATCH = 16
SEQ = 256
DEPTH = 1
DEC_BATCH = 2
DEC_SEQ = 2048
PAST_LEN = 512

GRID_W = 64
MIX_WIDTH = D_MODEL
POOL_WIDTH = MIX_WIDTH // 2
POOL_WINDOWS = (2, 4, 8, 16)
POOL_GROUPS = len(POOL_WINDOWS)
POOL_GROUP_DIM = POOL_WIDTH // POOL_GROUPS
N_HEADS = 8
QK_NOPE_DIM = 128
QK_ROPE_DIM = 64
QK_DIM = QK_NOPE_DIM + QK_ROPE_DIM
V_DIM = 128
ATTN_WIDTH = N_HEADS * V_DIM
Q_LORA = 512
KV_LORA = 256
IN_WIDTH = POOL_WIDTH + Q_LORA + KV_LORA + QK_ROPE_DIM
D_FF = 5632
CONV_W = 3
N_MOD = 6
ROPE_THETA = 10000.0
EPS = 1e-6
Q_BLOCK = 128
ATTN_SCALE = QK_DIM ** -0.5

kernel_name = "hybrid_pool_mla_prefix_diffusion_step"


def rmsnorm(x, g):
    xf = x.astype(jnp.float32)
    xf = xf * lax.rsqrt(jnp.mean(xf * xf, axis=-1, keepdims=True) + EPS)
    return (xf * g.astype(jnp.float32)).astype(x.dtype)


def modulation(cond, w_mod, b_mod):
    m = jax.nn.silu(cond) @ w_mod + b_mod
    m = m.reshape(m.shape[0], 1, N_MOD, D_MODEL)
    return (m[:, :, 0], m[:, :, 1], m[:, :, 2], m[:, :, 3], m[:, :, 4], m[:, :, 5])


def axial_rope_tables(n_tokens, dtype):
    rows = n_tokens // GRID_W
    row = jnp.repeat(jnp.arange(rows), GRID_W).astype(jnp.float32)
    col = jnp.tile(jnp.arange(GRID_W), rows).astype(jnp.float32)
    n_freq = QK_ROPE_DIM // 4
    inv = ROPE_THETA ** (-jnp.arange(n_freq, dtype=jnp.float32) / n_freq)
    ar = row[:, None] * inv
    ac = col[:, None] * inv
    ang = jnp.concatenate([ar, ar, ac, ac], axis=-1)
    return jnp.cos(ang).astype(dtype), jnp.sin(ang).astype(dtype)


def rope_heads(x, cos, sin):
    nope, pe = x[..., :QK_NOPE_DIM], x[..., QK_NOPE_DIM:]
    a1, a2, b1, b2 = jnp.split(pe, 4, axis=-1)
    rot = jnp.concatenate([-a2, a1, -b2, b1], axis=-1)
    pe = pe * cos[:, None, :] + rot * sin[:, None, :]
    return jnp.concatenate([nope, pe], axis=-1)


def multi_scale_pool(u, w_pool, pool_scale):
    B, T, _ = u.shape
    cs = jnp.pad(jnp.cumsum(u.astype(jnp.float32), axis=1), ((0, 0), (1, 0), (0, 0)))
    t = jnp.arange(T)
    outs = []
    for g, w in enumerate(POOL_WINDOWS):
        lo = jnp.clip(t - w // 2, 0, T - 1)
        hi = jnp.clip(t - w // 2 + w - 1, 0, T - 1)
        sl = slice(g * POOL_GROUP_DIM, (g + 1) * POOL_GROUP_DIM)
        cg = cs[:, :, sl]
        s = jnp.take(cg, hi + 1, axis=1) - jnp.take(cg, lo, axis=1)
        cnt = (hi - lo + 1).astype(jnp.float32)[None, :, None]
        d = (s / cnt - u[:, :, sl].astype(jnp.float32)).astype(u.dtype)
        outs.append(d @ w_pool[g])
    return jnp.concatenate(outs, axis=-1) * pool_scale


def mla_keys_values(ckv_n, kpe, w_ukv, k_norm_g):
    B, S, _ = ckv_n.shape
    kv = (ckv_n @ w_ukv).reshape(B, S, N_HEADS, QK_NOPE_DIM + V_DIM)
    k_nope, v = kv[..., :QK_NOPE_DIM], kv[..., QK_NOPE_DIM:]
    k_pe = jnp.broadcast_to(kpe[:, :, None, :], (B, S, N_HEADS, QK_ROPE_DIM))
    k = rmsnorm(jnp.concatenate([k_nope, k_pe], axis=-1), k_norm_g)
    return k, v


def block_attention(q, k, v):
    B, T, H, _ = q.shape
    nb = T // Q_BLOCK
    qb = q.reshape(B, nb, Q_BLOCK, H, QK_DIM).transpose(1, 0, 2, 3, 4)

    def one_block(qi):
        s = jnp.einsum('bqhd,bshd->bhqs', qi, k).astype(jnp.float32) * ATTN_SCALE
        p = jax.nn.softmax(s, axis=-1).astype(v.dtype)
        return jnp.einsum('bhqs,bshd->bqhd', p, v)

    o = lax.map(one_block, qb)
    return o.transpose(1, 0, 2, 3, 4).reshape(B, T, H * V_DIM)


def conv_ffn(h, w_up, conv_w, conv_b, w_down):
    up = h @ w_up
    p = jnp.pad(up, ((0, 0), (1, 1), (0, 0)))
    z = p[:, :-2] * conv_w[0] + p[:, 1:-1] * conv_w[1] + p[:, 2:] * conv_w[2] + conv_b
    a, b = z[..., :D_FF], z[..., D_FF:]
    return (jax.nn.silu(a) * b) @ w_down


def trunk_layer(x, mod, ctx_ckv, ctx_kpe, rope, lp):
    shift1, scale1, gate1, shift2, scale2, gate2 = mod
    B, T, _ = x.shape
    h = rmsnorm(x, lp['norm1_g']) * (1 + scale1) + shift1
    proj = h @ lp['w_in']
    o1 = POOL_WIDTH
    o2 = o1 + Q_LORA
    o3 = o2 + KV_LORA
    u, cq, ckv, kpe = proj[..., :o1], proj[..., o1:o2], proj[..., o2:o3], proj[..., o3:]
    pool_out = multi_scale_pool(u, lp['w_pool'], lp['pool_scale'])
    ckv_n = rmsnorm(ckv, lp['kv_a_g'])
    q = (rmsnorm(cq, lp['q_a_g']) @ lp['w_uq']).reshape(B, T, N_HEADS, QK_DIM)
    q = rmsnorm(q, lp['q_norm_g'])
    k, v = mla_keys_values(ckv_n, kpe, lp['w_ukv'], lp['k_norm_g'])
    if rope is not None:
        cos, sin = rope
        q = rope_heads(q, cos, sin)
        k = rope_heads(k, cos, sin)
    if ctx_ckv is not None:
        ck, cv = mla_keys_values(ctx_ckv, ctx_kpe, lp['w_ukv'], lp['k_norm_g'])
        k = jnp.concatenate([ck, k], axis=1)
        v = jnp.concatenate([cv, v], axis=1)
    att = block_attention(q, k, v)
    mixed = jnp.concatenate([pool_out, att], axis=-1) @ lp['w_out']
    x = x + gate1 * mixed
    h2 = rmsnorm(x, lp['norm2_g']) * (1 + scale2) + shift2
    x = x + gate2 * conv_ffn(h2, lp['w_up'], lp['conv_w'], lp['conv_b'], lp['w_down'])
    return x, ckv_n, kpe


def setup_inputs(seed: int = 0) -> dict:
    key = jax.random.key(seed)
    ks = jax.random.split(key, 32)
    f = jnp.float32

    def nrm(k, shape, scale):
        return jax.random.normal(k, shape, f) * scale

    L = DEPTH
    return {
        'x_prompt': nrm(ks[0], (BATCH, SEQ, D_MODEL), 1.0),
        'x_sample': nrm(ks[1], (DEC_BATCH, DEC_SEQ, D_MODEL), 1.0),
        'cache_ckv': nrm(ks[2], (DEC_BATCH, DEPTH, PAST_LEN, KV_LORA), 1.0),
        'cache_kpe': nrm(ks[3], (DEC_BATCH, DEPTH, PAST_LEN, QK_ROPE_DIM), 1.0),
        'c': nrm(ks[4], (DEC_BATCH, D_MODEL), 1.0),
        'c_ctx': nrm(ks[5], (D_MODEL,), 1.0),
        'norm1_g': 1.0 + nrm(ks[6], (L, D_MODEL), 0.05),
        'norm2_g': 1.0 + nrm(ks[7], (L, D_MODEL), 0.05),
        'w_mod': nrm(ks[8], (L, D_MODEL, N_MOD * D_MODEL), 0.5 * D_MODEL ** -0.5),
        'b_mod': nrm(ks[9], (L, N_MOD * D_MODEL), 0.02),
        'w_in': nrm(ks[10], (L, D_MODEL, IN_WIDTH), D_MODEL ** -0.5),
        'w_pool': nrm(ks[11], (L, POOL_GROUPS, POOL_GROUP_DIM, POOL_GROUP_DIM), POOL_GROUP_DIM ** -0.5),
        'pool_scale': 1.0 + nrm(ks[12], (L, POOL_WIDTH), 0.1),
        'q_a_g': 1.0 + nrm(ks[13], (L, Q_LORA), 0.05),
        'w_uq': nrm(ks[14], (L, Q_LORA, N_HEADS * QK_DIM), Q_LORA ** -0.5),
        'kv_a_g': 1.0 + nrm(ks[15], (L, KV_LORA), 0.05),
        'w_ukv': nrm(ks[16], (L, KV_LORA, N_HEADS * (QK_NOPE_DIM + V_DIM)), KV_LORA ** -0.5),
        'q_norm_g': 1.0 + nrm(ks[17], (L, QK_DIM), 0.05),
        'k_norm_g': 1.0 + nrm(ks[18], (L, QK_DIM), 0.05),
        'w_out': nrm(ks[19], (L, MIX_WIDTH, D_MODEL), MIX_WIDTH ** -0.5),
        'w_up': nrm(ks[20], (L, D_MODEL, 2 * D_FF), D_MODEL ** -0.5),
        'conv_w': nrm(ks[21], (L, CONV_W, 2 * D_FF), 0.3) + jnp.array([0.0, 1.0, 0.0], f)[None, :, None],
        'conv_b': nrm(ks[22], (L, 2 * D_FF), 0.02),
        'w_down': nrm(ks[23], (L, D_FF, D_MODEL), D_FF ** -0.5),
    }


def reference(x_prompt, x_sample, cache_ckv, cache_kpe, c, c_ctx, norm1_g, norm2_g,
              w_mod, b_mod, w_in, w_pool, pool_scale, q_a_g, w_uq, kv_a_g, w_ukv,
              q_norm_g, k_norm_g, w_out, w_up, conv_w, conv_b, w_down):
    rope = axial_rope_tables(x_sample.shape[1], x_sample.dtype)
    xp = x_prompt
    xs = x_sample
    ckv_list = []
    kpe_list = []
    for l in range(DEPTH):
        lp = {
            'norm1_g': norm1_g[l], 'norm2_g': norm2_g[l], 'w_in': w_in[l],
            'w_pool': w_pool[l], 'pool_scale': pool_scale[l], 'q_a_g': q_a_g[l],
            'w_uq': w_uq[l], 'kv_a_g': kv_a_g[l], 'w_ukv': w_ukv[l],
            'q_norm_g': q_norm_g[l], 'k_norm_g': k_norm_g[l], 'w_out': w_out[l],
            'w_up': w_up[l], 'conv_w': conv_w[l], 'conv_b': conv_b[l], 'w_down': w_down[l],
        }
        mod_ctx = modulation(c_ctx[None, :], w_mod[l], b_mod[l])
        xp, ckv_n, kpe = trunk_layer(xp, mod_ctx, None, None, None, lp)
        ckv_list.append(ckv_n)
        kpe_list.append(kpe)
        mod_lat = modulation(c, w_mod[l], b_mod[l])
        xs, _, _ = trunk_layer(xs, mod_lat, cache_ckv[:, l], cache_kpe[:, l], rope, lp)
    new_ckv = jnp.stack(ckv_list, axis=1)
    new_kpe = jnp.stack(kpe_list, axis=1)
    return (xp, xs, new_ckv, new_kpe)
```

```cpp
#include <hip/hip_runtime.h>
#include <cstdio>
#include <cstdint>
namespace pg8 {
#define PG8_LAS __attribute__((address_space(3)))
typedef unsigned short bf16_t;
typedef short bf16x8 __attribute__((ext_vector_type(8)));
typedef float f32x4 __attribute__((ext_vector_type(4)));
typedef float f32x2 __attribute__((ext_vector_type(2)));
typedef unsigned u32x4 __attribute__((ext_vector_type(4)));
typedef unsigned u32x2 __attribute__((ext_vector_type(2)));
constexpr int BM = 256, BK = 64, HALF = 128, HTB = HALF * BK * 2  , STAGE_BYTES = 8 * HTB, NXCD = 8, WGM = 8;

__host__ __device__ __forceinline__ int lds_byte(int r, int c) { const int st = (r >> 4) * 2 + (c >> 5), rr = r & 15, cc = c & 31, ob = rr * 64 + cc * 2; return st * 1024 + (ob ^ (((ob >> 9) & 1) << 5)); }
__host__ __device__ __forceinline__ void stage_rc(int b, int& R, int& C) { const int st = b / 1024, sb = b % 1024, swz = sb ^ (((sb >> 9) & 1) << 5); R = (st >> 1) * 16 + swz / 64; C = (st & 1) * 32 + (swz % 64) / 2; }
__host__ __device__ __forceinline__ int perm32(int rho) { const int n = rho >> 4, i = rho & 15; return 8 * (i >> 2) + 4 * n + (i & 3); }

struct Unit { int pm, pn; };
struct Gemm { const bf16_t* A; const bf16_t* Bt; };
template <int LDA, int LDB, int KK, int APN> struct Geo { static constexpr int lda = LDA, ldb = LDB, K = KK, a_pn_bytes = APN; };

struct StaticOrder {
    int nM, nN, nwg, G, c;
    __host__ __device__ void init(int M, int N, int G_, int c_) { nM = M / BM; nN = N / BM; nwg = nM * nN; G = G_; c = c_; }
    __host__ __device__ bool next(int i, Unit& u) const {
        const long L = (long)i * G + c; if (L >= nwg) return false;
        int wgid = (int)L; { const int q = nwg / NXCD, r = nwg % NXCD, xcd = wgid % NXCD, off = wgid / NXCD; wgid = (xcd < r ? xcd * (q + 1) : r * (q + 1) + (xcd - r) * q) + off; }
        const int nig = WGM * nN, gid = wgid / nig, fm = gid * WGM, gsz = (nM - fm) < WGM ? (nM - fm) : WGM;
        u.pm = fm + ((wgid % nig) % gsz); u.pn = (wgid % nig) / gsz; return true;
    }
};

__device__ __forceinline__ unsigned cvt_pk_bf16(float lo, float hi) { unsigned r; asm volatile("v_cvt_pk_bf16_f32 %0, %1, %2" : "=v"(r) : "v"(lo), "v"(hi)); return r; }


template <class GEO, class Epi, class Sched>
__device__ __forceinline__ void gemm_phase(PG8_LAS unsigned char* lds, PG8_LAS float* sx, const Gemm g, const Sched& S, const Epi& E) {
    int tid_ = threadIdx.x; asm volatile("" : "+v"(tid_));
    const int tid = tid_, wid = __builtin_amdgcn_readfirstlane(tid >> 6), lane = tid & 63, wr = wid >> 2, wc = wid & 3, fr = lane & 15, fq = lane >> 4;
    constexpr int K = GEO::K, nt = K / BK;
    unsigned voffA[2], voffB[2];
#pragma unroll
    for (int i = 0; i < 2; ++i) { int R, C; stage_rc(tid * 16 + i * 8192, R, C); const int Rb = Epi::PERM ? ((R & ~31) + perm32(R & 31)) : R;
        voffA[i] = (unsigned)(R * GEO::lda + C) * 2u; voffB[i] = (unsigned)(Rb * GEO::ldb + C) * 2u; }
    const size_t kstep = (size_t)(BK * 2);
    const size_t hstepA = (size_t)HALF * GEO::lda * 2, hstepB = (size_t)HALF * GEO::ldb * 2;
    const size_t tstepA = 2 * hstepA, tstepB = 2 * hstepB;
    const unsigned ldsw = (unsigned)wid * 1024u;
    const int aoff = lds_byte(wr * 64 + fr, fq * 8), boff = lds_byte(wc * 32 + fr, fq * 8);
#define PG8_SA(b, h) (((b) * 2 + (h)) * HTB)
#define PG8_SB(b, h) ((4 + (b) * 2 + (h)) * HTB)
#define PG8_STAGE(bufoff, gbase, voff) do { _Pragma("unroll") for (int _i = 0; _i < 2; ++_i) \
        __builtin_amdgcn_global_load_lds((const unsigned*)((const char*)(gbase) + (voff)[_i]), (PG8_LAS unsigned*)(lds + (bufoff) + ldsw + _i * 8192), 16, 0, 0); } while (0)
#define PG8_LDA(dst, b, h) do { _Pragma("unroll") for (int m = 0; m < 4; ++m) _Pragma("unroll") for (int k = 0; k < 2; ++k) dst[m][k] = *(const PG8_LAS bf16x8*)(lds + PG8_SA(b, h) + aoff + m * 2048 + k * 1024); } while (0)
#define PG8_LDB(dst, b, h) do { _Pragma("unroll") for (int n = 0; n < 2; ++n) _Pragma("unroll") for (int k = 0; k < 2; ++k) dst[n][k] = *(const PG8_LAS bf16x8*)(lds + PG8_SB(b, h) + boff + n * 2048 + k * 1024); } while (0)
#define PG8_MMA(ai, bj, At, Bt) do { __builtin_amdgcn_s_setprio(1); _Pragma("unroll") for (int m = 0; m < 4; ++m) _Pragma("unroll") for (int n = 0; n < 2; ++n) _Pragma("unroll") for (int k = 0; k < 2; ++k) \
        acc[ai][bj][m][n] = __builtin_amdgcn_mfma_f32_16x16x32_bf16(Bt[n][k], At[m][k], acc[ai][bj][m][n], 0, 0, 0); __builtin_amdgcn_s_setprio(0); } while (0)
#define PG8_WAIT_V(n) asm volatile("s_waitcnt vmcnt(" #n ")" ::: "memory")
#define PG8_WAIT_L(n) asm volatile("s_waitcnt lgkmcnt(" #n ")" ::: "memory")
#define PG8_BAR __builtin_amdgcn_s_barrier()
#define PG8_SCHED __builtin_amdgcn_sched_barrier(0)
    Unit cur, nxt; int ui = 0;
    if (!S.next(0, cur)) return;
    f32x4 acc[2][2][4][2];
#pragma unroll
    for (int a = 0; a < 2; ++a)
#pragma unroll
        for (int b = 0; b < 2; ++b)
#pragma unroll
            for (int m = 0; m < 4; ++m)
#pragma unroll
                for (int n = 0; n < 2; ++n) acc[a][b][m][n] = (f32x4){0.f, 0.f, 0.f, 0.f};
    bf16x8 At[4][2], B0[2][2], B1[2][2];
    const char* cA = (const char*)g.A + (size_t)cur.pm * tstepA + (size_t)cur.pn * GEO::a_pn_bytes; const char* cB = (const char*)g.Bt + (size_t)cur.pn * tstepB;
    PG8_STAGE(PG8_SB(0, 0), cB, voffB); PG8_STAGE(PG8_SB(0, 1), cB + hstepB, voffB); PG8_STAGE(PG8_SA(0, 0), cA, voffA); PG8_STAGE(PG8_SA(0, 1), cA + hstepA, voffA);
    if (wr == 1) PG8_BAR;
    PG8_WAIT_V(2); PG8_BAR;
    PG8_STAGE(PG8_SB(1, 0), cB + kstep, voffB); PG8_STAGE(PG8_SA(1, 0), cA + kstep, voffA); PG8_STAGE(PG8_SB(1, 1), cB + hstepB + kstep, voffB);
    PG8_WAIT_V(6); PG8_BAR;
    for (;;) {
        const bool has_next = S.next(ui + 1, nxt);
        const char* nA = has_next ? (const char*)g.A + (size_t)nxt.pm * tstepA + (size_t)nxt.pn * GEO::a_pn_bytes : cA; const char* nB = has_next ? (const char*)g.Bt + (size_t)nxt.pn * tstepB : cB;
#pragma unroll 1
        for (int t = 0; t < nt; t += 2) {
            const bool last = (t == nt - 2);
            const char* a1 = cA + (size_t)(t + 1) * kstep;
            const char* a2 = last ? nA : cA + (size_t)(t + 2) * kstep; const char* b2 = last ? nB : cB + (size_t)(t + 2) * kstep;
            const char* a3 = a2 + kstep; const char* b3 = b2 + kstep;
            PG8_LDB(B0, 0, 0); PG8_LDB(B1, 0, 1); PG8_SCHED; PG8_LDA(At, 0, 0); PG8_STAGE(PG8_SA(1, 1), a1 + hstepA, voffA);
            PG8_WAIT_V(8); PG8_WAIT_L(0); PG8_BAR; PG8_MMA(0, 0, At, B0); PG8_MMA(0, 1, At, B1); PG8_BAR; PG8_SCHED;
            PG8_LDA(At, 0, 1); PG8_STAGE(PG8_SB(0, 0), b2, voffB); PG8_STAGE(PG8_SB(0, 1), b2 + hstepB, voffB); PG8_STAGE(PG8_SA(0, 0), a2, voffA);
            PG8_WAIT_V(8); PG8_WAIT_L(0); PG8_BAR; PG8_MMA(1, 0, At, B0); PG8_MMA(1, 1, At, B1); PG8_BAR; PG8_SCHED;
            PG8_LDB(B0, 1, 0); PG8_LDB(B1, 1, 1); PG8_SCHED; PG8_LDA(At, 1, 0); PG8_STAGE(PG8_SA(0, 1), a2 + hstepA, voffA);
            PG8_WAIT_V(8); PG8_WAIT_L(0); PG8_BAR; PG8_MMA(0, 0, At, B0); PG8_MMA(0, 1, At, B1); PG8_BAR; PG8_SCHED;
            PG8_LDA(At, 1, 1); PG8_STAGE(PG8_SB(1, 0), b3, voffB); PG8_STAGE(PG8_SB(1, 1), b3 + hstepB, voffB); PG8_STAGE(PG8_SA(1, 0), a3, voffA);
            PG8_WAIT_V(8); PG8_WAIT_L(0); PG8_BAR; PG8_MMA(1, 0, At, B0); PG8_MMA(1, 1, At, B1); PG8_BAR; PG8_SCHED;
        }
        if (wr == 0) PG8_BAR;
        { int fr_ = fr, fq_ = fq; asm volatile("" : "+v"(fr_), "+v"(fq_));
          E(acc, cur, wr, wc, fr_, fq_, sx); }
        if (!has_next) break;
#pragma unroll
        for (int a = 0; a < 2; ++a)
#pragma unroll
            for (int b = 0; b < 2; ++b)
#pragma unroll
                for (int m = 0; m < 4; ++m)
#pragma unroll
                    for (int n = 0; n < 2; ++n) acc[a][b][m][n] = (f32x4){0.f, 0.f, 0.f, 0.f};
        cur = nxt; cA = nA; cB = nB; ++ui;
        if (wr == 1) PG8_BAR;
    }
    PG8_WAIT_V(0);
    PG8_BAR;
#undef PG8_SA
#undef PG8_SB
#undef PG8_STAGE
#undef PG8_LDA
#undef PG8_LDB
#undef PG8_MMA
}
}
constexpr int DM = 2048, NTOK = 8192, NCTX = 4096, LAT_T = 2048, LAT_B = 2, CTX_T = 256, PAST = 512;
constexpr int KVSEG = PAST + LAT_T;
constexpr int KVROWS = NCTX + LAT_B * KVSEG;
constexpr int POOLW = 1024, QLORA = 512, KVLORA = 256, ROPED = 64, INW = 1856, NH = 8, DQK = 192, DNOPE = 128, DVH = 128, DFF = 5632, NMOD = 6;
constexpr float EPSN = 1e-6f;

__device__ __forceinline__ int kvrow_of(int row) { return row < NCTX ? row : NCTX + ((row - NCTX) >> 11) * KVSEG + PAST + ((row - NCTX) & (LAT_T - 1)); }

namespace epi {
using namespace pg8;
#define EPI_LAS __attribute__((address_space(3)))
__device__ __forceinline__ float fq_sum(float s) { s += __shfl_xor(s, 16); s += __shfl_xor(s, 32); return s; }
__device__ __forceinline__ void lds_bar() { asm volatile("s_waitcnt lgkmcnt(0)" ::: "memory"); __builtin_amdgcn_s_barrier(); asm volatile("" ::: "memory"); }
__device__ __forceinline__ u32x4 pack8(const f32x4 a, const f32x4 b) { u32x4 w; w.x = cvt_pk_bf16(a[0], a[1]); w.y = cvt_pk_bf16(a[2], a[3]); w.z = cvt_pk_bf16(b[0], b[1]); w.w = cvt_pk_bf16(b[2], b[3]); return w; }
__device__ __forceinline__ float sq4(const f32x4 v) { return (v[0] * v[0] + v[1] * v[1]) + (v[2] * v[2] + v[3] * v[3]); }

template <int ldc> struct EpiBf16 {
    static constexpr bool PERM = true;
    bf16_t* O;
    __device__ __forceinline__ void operator()(const f32x4 (&acc)[2][2][4][2], const Unit& u, int wr, int wc, int fr, int fq, EPI_LAS float*) const {
        const int row0 = u.pm * BM + wr * 64 + fr, col0 = u.pn * BM + wc * 32 + 8 * fq;
#pragma unroll
        for (int ai = 0; ai < 2; ++ai)
#pragma unroll
            for (int m = 0; m < 4; ++m) { bf16_t* rowp = O + (size_t)(row0 + ai * HALF + m * 16) * ldc + col0;
#pragma unroll
                for (int bj = 0; bj < 2; ++bj) *(u32x4*)(rowp + bj * HALF) = pack8(acc[ai][bj][m][0], acc[ai][bj][m][1]); }
    }
};

__device__ __forceinline__ f32x4 rope4(const f32x4 w, const float* tab, int pos, int fq, int n) {
    f32x4 p; p[0] = __shfl_xor(w[0], 32); p[1] = __shfl_xor(w[1], 32); p[2] = __shfl_xor(w[2], 32); p[3] = __shfl_xor(w[3], 32);
    const float* tp = tab + ((size_t)pos * 16 + 8 * (fq & 1) + 4 * n) * 2;
    const f32x4 c0 = *(const f32x4*)tp, c1 = *(const f32x4*)(tp + 4);
    const float sg = (fq < 2) ? -1.f : 1.f;
    f32x4 o; o[0] = w[0] * c0[0] + sg * p[0] * c0[1]; o[1] = w[1] * c0[2] + sg * p[1] * c0[3]; o[2] = w[2] * c1[0] + sg * p[2] * c1[1]; o[3] = w[3] * c1[2] + sg * p[3] * c1[3];
    return o;
}

struct EpiIn {
    static constexpr bool PERM = true;
    bf16_t* U; bf16_t* CQ; bf16_t* CKVN; float* SSQQ; float* SSQK; float* KPW; float* out_ckv; float* out_kpe;
    const float* kv_a_g; const float* k_norm_g; const float* tab;
    __device__ __forceinline__ void operator()(const f32x4 (&acc)[2][2][4][2], const Unit& u, int wr, int wc, int fr, int fq, EPI_LAS float* part) const {
        const int pn = u.pn, rl0 = wr * 64 + fr, row0 = u.pm * BM + rl0, cl0 = wc * 32 + 8 * fq;
        if (pn < 4) {
#pragma unroll
            for (int ai = 0; ai < 2; ++ai)
#pragma unroll
                for (int m = 0; m < 4; ++m) { bf16_t* rowp = U + (size_t)(row0 + ai * HALF + m * 16) * POOLW + pn * BM + cl0;
#pragma unroll
                    for (int bj = 0; bj < 2; ++bj) *(u32x4*)(rowp + bj * HALF) = pack8(acc[ai][bj][m][0], acc[ai][bj][m][1]); }
            return;
        }
        const bool kpe_tile = (pn == 7);
#pragma unroll
        for (int ai = 0; ai < 2; ++ai)
#pragma unroll
            for (int m = 0; m < 4; ++m) {
                float s = sq4(acc[ai][0][m][0]) + sq4(acc[ai][0][m][1]);
                if (kpe_tile) { if (wc >= 2) s = 0.f; } else s += sq4(acc[ai][1][m][0]) + sq4(acc[ai][1][m][1]);
                s = fq_sum(s);
                if (fq == 0) part[(ai * HALF + rl0 + m * 16) * 4 + wc] = s;
            }
        lds_bar();
        if (pn < 6) {
#pragma unroll
            for (int ai = 0; ai < 2; ++ai)
#pragma unroll
                for (int m = 0; m < 4; ++m) { const int rl = ai * HALF + rl0 + m * 16, row = u.pm * BM + rl;
                    bf16_t* rowp = CQ + (size_t)row * QLORA + (pn - 4) * BM + cl0;
#pragma unroll
                    for (int bj = 0; bj < 2; ++bj) *(u32x4*)(rowp + bj * HALF) = pack8(acc[ai][bj][m][0], acc[ai][bj][m][1]);
                    if (wc == 0 && fq == 0) { const f32x4 p4 = *(const EPI_LAS f32x4*)(part + rl * 4); SSQQ[(pn - 4) * NTOK + row] = (p4[0] + p4[1]) + (p4[2] + p4[3]); } }
        } else if (pn == 6) {
            f32x4 gv[2][2];
#pragma unroll
            for (int bj = 0; bj < 2; ++bj)
#pragma unroll
                for (int n = 0; n < 2; ++n) gv[bj][n] = *(const f32x4*)(kv_a_g + bj * HALF + cl0 + 4 * n);
#pragma unroll
            for (int ai = 0; ai < 2; ++ai)
#pragma unroll
                for (int m = 0; m < 4; ++m) { const int rl = ai * HALF + rl0 + m * 16, row = u.pm * BM + rl;
                    const f32x4 p4 = *(const EPI_LAS f32x4*)(part + rl * 4); const float rstd = 1.0f / sqrtf(((p4[0] + p4[1]) + (p4[2] + p4[3])) * (1.0f / KVLORA) + EPSN);
                    bf16_t* rowp = CKVN + (size_t)kvrow_of(row) * KVLORA + cl0;
#pragma unroll
                    for (int bj = 0; bj < 2; ++bj) { const f32x4 v0 = acc[ai][bj][m][0] * rstd * gv[bj][0], v1 = acc[ai][bj][m][1] * rstd * gv[bj][1];
                        *(u32x4*)(rowp + bj * HALF) = pack8(v0, v1);
                        if (row < NCTX) { float* op = out_ckv + (size_t)row * KVLORA + bj * HALF + cl0; *(f32x4*)op = v0; *(f32x4*)(op + 4) = v1; } } }
        } else {
            const bool lat = (u.pm >= NCTX / BM);
            if (wc < 2) {
                f32x4 gv[2];
#pragma unroll
                for (int n = 0; n < 2; ++n) gv[n] = *(const f32x4*)(k_norm_g + DNOPE + cl0 + 4 * n);
#pragma unroll
                for (int ai = 0; ai < 2; ++ai)
#pragma unroll
                    for (int m = 0; m < 4; ++m) { const int rl = ai * HALF + rl0 + m * 16, row = u.pm * BM + rl, kr = kvrow_of(row);
#pragma unroll
                        for (int n = 0; n < 2; ++n) { f32x4 w = acc[ai][0][m][n] * gv[n];
                            if (lat) { const int t = (row - NCTX) & (LAT_T - 1); w = rope4(w, tab, wc == 0 ? (t >> 6) : (t & 63), fq, n); }
                            else *(f32x4*)(out_kpe + (size_t)row * ROPED + cl0 + 4 * n) = acc[ai][0][m][n];
                            *(f32x4*)(KPW + (size_t)kr * ROPED + cl0 + 4 * n) = w; }
                        if (wc == 0 && fq == 0) { const f32x4 p4 = *(const EPI_LAS f32x4*)(part + rl * 4); SSQK[kr] = (p4[0] + p4[1]) + (p4[2] + p4[3]); } }
            }
        }
    }
};

struct EpiQ {
    static constexpr bool PERM = true;
    bf16_t* Q; const float* SSQQ; const float* q_norm_g; const float* tab;
    __device__ __forceinline__ void operator()(f32x4 (&acc)[2][2][4][2], const Unit& u, int wr, int wc, int fr, int fq, EPI_LAS float* part) const {
        const int h = u.pn, rl0 = wr * 64 + fr, cl0 = wc * 32 + 8 * fq; const bool lat = (u.pm >= NCTX / BM), v1ok = (wc < 2);
#pragma unroll
        for (int ai = 0; ai < 2; ++ai)
#pragma unroll
            for (int m = 0; m < 4; ++m) { const int rl = ai * HALF + rl0 + m * 16, row = u.pm * BM + rl;
                const float rc = 1.0f / sqrtf((SSQQ[row] + SSQQ[NTOK + row]) * (1.0f / QLORA) + EPSN);
#pragma unroll
                for (int bj = 0; bj < 2; ++bj)
#pragma unroll
                    for (int n = 0; n < 2; ++n) acc[ai][bj][m][n] = acc[ai][bj][m][n] * rc;
                float s = sq4(acc[ai][0][m][0]) + sq4(acc[ai][0][m][1]);
                if (v1ok) s += sq4(acc[ai][1][m][0]) + sq4(acc[ai][1][m][1]);
                s = fq_sum(s);
                if (fq == 0) part[rl * 4 + wc] = s;
            }
        lds_bar();
        f32x4 gv[2][2];
#pragma unroll
        for (int bj = 0; bj < 2; ++bj)
#pragma unroll
            for (int n = 0; n < 2; ++n) gv[bj][n] = (bj == 0 || v1ok) ? *(const f32x4*)(q_norm_g + bj * HALF + cl0 + 4 * n) : (f32x4){0.f, 0.f, 0.f, 0.f};
#pragma unroll
        for (int ai = 0; ai < 2; ++ai)
#pragma unroll
            for (int m = 0; m < 4; ++m) { const int rl = ai * HALF + rl0 + m * 16, row = u.pm * BM + rl;
                const f32x4 p4 = *(const EPI_LAS f32x4*)(part + rl * 4); const float rn = 1.0f / sqrtf(((p4[0] + p4[1]) + (p4[2] + p4[3])) * (1.0f / DQK) + EPSN);
                bf16_t* rowp = Q + (size_t)row * (NH * DQK) + h * DQK + cl0;
                *(u32x4*)rowp = pack8(acc[ai][0][m][0] * rn * gv[0][0], acc[ai][0][m][1] * rn * gv[0][1]);
                if (v1ok) { f32x4 w0 = acc[ai][1][m][0] * rn * gv[1][0], w1 = acc[ai][1][m][1] * rn * gv[1][1];
                    if (lat) { const int t = (row - NCTX) & (LAT_T - 1), pos = (wc == 0) ? (t >> 6) : (t & 63); w0 = rope4(w0, tab, pos, fq, 0); w1 = rope4(w1, tab, pos, fq, 1); }
                    *(u32x4*)(rowp + HALF) = pack8(w0, w1); } }
    }
};

#define EPI_PIN(x) asm volatile("" : "+v"(x))
#define EPI_FENCE() asm volatile("" ::: "memory")
struct EpiKV {
    static constexpr bool PERM = true;
    bf16_t* Kb; bf16_t* Vb; const float* SSQK; const float* KPW; const float* k_norm_g;
    __device__ __forceinline__ void operator()(const f32x4 (&acc)[2][2][4][2], const Unit& u, int wr, int wc, int fr, int fq, EPI_LAS float* part) const {
        const int h = u.pn, rl0 = wr * 64 + fr, cl0 = wc * 32 + 8 * fq, e = 16 * wc + 4 * fq;
        float sk[4]; f32x4 kw[4];
        int kr0 = u.pm * BM + rl0; EPI_PIN(kr0);
#pragma unroll
        for (int m = 0; m < 4; ++m) { const int kr = kr0 + m * 16; sk[m] = SSQK[kr]; kw[m] = *(const f32x4*)(KPW + (size_t)kr * ROPED + e); }
#pragma unroll
        for (int ai = 0; ai < 2; ++ai)
#pragma unroll
            for (int m = 0; m < 4; ++m) { float s = sq4(acc[ai][0][m][0]) + sq4(acc[ai][0][m][1]); s = fq_sum(s); if (fq == 0) part[(ai * HALF + rl0 + m * 16) * 4 + wc] = s; }
        lds_bar();
        f32x4 gv[2];
#pragma unroll
        for (int n = 0; n < 2; ++n) gv[n] = *(const f32x4*)(k_norm_g + cl0 + 4 * n);
#pragma unroll
        for (int ai = 0; ai < 2; ++ai) {
            if (ai == 1) { int kr1 = u.pm * BM + HALF + rl0; EPI_PIN(kr1);
#pragma unroll
                for (int m = 0; m < 4; ++m) { const int kr = kr1 + m * 16; sk[m] = SSQK[kr]; kw[m] = *(const f32x4*)(KPW + (size_t)kr * ROPED + e); } }
#pragma unroll
            for (int m = 0; m < 4; ++m) { const int rl = ai * HALF + rl0 + m * 16; int kr = u.pm * BM + rl; EPI_PIN(kr);
                const f32x4 p4 = *(const EPI_LAS f32x4*)(part + rl * 4); const float rk = 1.0f / sqrtf((((p4[0] + p4[1]) + (p4[2] + p4[3])) + sk[m]) * (1.0f / DQK) + EPSN);
                bf16_t* kp = Kb + (size_t)kr * (NH * DQK) + h * DQK;
                *(u32x4*)(kp + cl0) = pack8(acc[ai][0][m][0] * rk * gv[0], acc[ai][0][m][1] * rk * gv[1]);
                *(u32x4*)(Vb + (size_t)kr * (NH * DVH) + h * DVH + cl0) = pack8(acc[ai][1][m][0], acc[ai][1][m][1]);
                const f32x4 kv = kw[m] * rk;
                u32x2 w; w.x = cvt_pk_bf16(kv[0], kv[1]); w.y = cvt_pk_bf16(kv[2], kv[3]); *(u32x2*)(kp + DNOPE + e) = w;
                EPI_FENCE(); }
        }
    }
};

struct EpiGateRes {
    static constexpr bool PERM = false;
    const float* base_ctx; const float* base_lat; float* out; const float* gate;
    __device__ __forceinline__ void operator()(const f32x4 (&acc)[2][2][4][2], const Unit& u, int wr, int wc, int fr, int fq, EPI_LAS float*) const {
        const int cond = (u.pm < NCTX / BM) ? 0 : 1 + (u.pm - NCTX / BM) / (LAT_T / BM);
        const int col0 = u.pn * BM + wc * 32 + 4 * fq; const float* gp = gate + (size_t)cond * (NMOD * DM) + col0;
        f32x4 gv[2][2];
#pragma unroll
        for (int bj = 0; bj < 2; ++bj)
#pragma unroll
            for (int n = 0; n < 2; ++n) gv[bj][n] = *(const f32x4*)(gp + bj * HALF + n * 16);
        const float* base = (u.pm < NCTX / BM) ? base_ctx : base_lat - (size_t)NCTX * DM;
#pragma unroll
        for (int ai = 0; ai < 2; ++ai)
#pragma unroll
            for (int m = 0; m < 4; ++m) { const size_t off = (size_t)(u.pm * BM + ai * HALF + wr * 64 + m * 16 + fr) * DM + col0;
#pragma unroll
                for (int bj = 0; bj < 2; ++bj)
#pragma unroll
                    for (int n = 0; n < 2; ++n) { const f32x4 bs = *(const f32x4*)(base + off + bj * HALF + n * 16); *(f32x4*)(out + off + bj * HALF + n * 16) = bs + gv[bj][n] * acc[ai][bj][m][n]; }
                if (m & 1) asm volatile("" ::: "memory"); }
    }
};
}
namespace att {
using bf16 = unsigned short;
constexpr int DQ = 192, DVV = 128, NW = 8, QBLK = 32, KVBLK = 64;
constexpr float SCALE = 0.07216878364870322f;
constexpr float THR = 8.f;
constexpr int LDQ = 8 * DQ, LDKK = 8 * DQ, LDVV = 8 * DVV, LDO = 2048;
constexpr int SHM_V = KVBLK * DVV * 2, SHM_K = KVBLK * DQ * 2, NQR = 6  , SHM_QR = NW * (12 - NQR) * 1024, SHM_ATTN = 2 * SHM_V + 2 * SHM_K + NW * 64 * 4 + SHM_QR;
using bf16x8 = __attribute__((ext_vector_type(8))) short;
using s16x4  = __attribute__((ext_vector_type(4))) short;
using f32x16 = __attribute__((ext_vector_type(16))) float;
using u32x4  = __attribute__((ext_vector_type(4))) unsigned;
#define KSWZ(row, colB) ((row) * 384 + ((colB) ^ ((((row) >> 1) & 7) << 4)))
#define SBAR() __builtin_amdgcn_sched_barrier(0)
__device__ __forceinline__ int crow(int r, int hi) { return (r & 3) + 8 * (r >> 2) + 4 * hi; }
__device__ __forceinline__ unsigned cvtpk(float lo, float hi) { unsigned r; asm volatile("v_cvt_pk_bf16_f32 %0, %1, %2" : "=v"(r) : "v"(lo), "v"(hi)); return r; }

__device__ __forceinline__ void partialSM(f32x16& p0, f32x16& p1, float& m_reg, float& mn, float& alpha) {
  constexpr float C = SCALE * 1.4426950408889634f;
  float pmax = p0[0];
#pragma unroll
  for (int r = 1; r < 16; ++r) pmax = fmaxf(pmax, p0[r]);
#pragma unroll
  for (int r = 0; r < 16; ++r) pmax = fmaxf(pmax, p1[r]);
  { auto rr = __builtin_amdgcn_permlane32_swap(__float_as_uint(pmax), __float_as_uint(pmax), false, false);
    pmax = fmaxf(__uint_as_float(rr[0]), __uint_as_float(rr[1])); }
  if (__builtin_expect(__all(pmax - m_reg <= THR / SCALE), 1)) { mn = m_reg; alpha = 1.f; }
  else { mn = fmaxf(m_reg, pmax); alpha = __builtin_amdgcn_exp2f((m_reg - mn) * C); m_reg = mn; }
  float mnC = -mn * C;
#pragma unroll
  for (int r = 0; r < 16; ++r) p0[r] = fmaf(p0[r], C, mnC);
#pragma unroll
  for (int r = 0; r < 16; ++r) p1[r] = fmaf(p1[r], C, mnC);
#pragma unroll
  for (int r = 0; r < 16; ++r) p0[r] = __builtin_amdgcn_exp2f(p0[r]);
}
__device__ __forceinline__ void finishSM(f32x16& p0, f32x16& p1, float alpha, float& l_reg, bf16x8& pa0, bf16x8& pa1, bf16x8& pa2, bf16x8& pa3) {
#pragma unroll
  for (int r = 0; r < 16; ++r) p1[r] = __builtin_amdgcn_exp2f(p1[r]);
  float ps = 0;
#pragma unroll
  for (int r = 0; r < 16; ++r) ps += p0[r];
#pragma unroll
  for (int r = 0; r < 16; ++r) ps += p1[r];
  { auto rr = __builtin_amdgcn_permlane32_swap(__float_as_uint(ps), __float_as_uint(ps), false, false);
    ps = __uint_as_float(rr[0]) + __uint_as_float(rr[1]); }
  l_reg = l_reg * alpha + ps;
#define PK4(P, BASE, OUT) do { unsigned a0 = cvtpk(P[BASE + 0], P[BASE + 1]), a1 = cvtpk(P[BASE + 2], P[BASE + 3]);   \
    unsigned b0 = cvtpk(P[BASE + 4], P[BASE + 5]), b1 = cvtpk(P[BASE + 6], P[BASE + 7]);                              \
    auto r0 = __builtin_amdgcn_permlane32_swap(a0, b0, false, false); auto r1 = __builtin_amdgcn_permlane32_swap(a1, b1, false, false); \
    u32x4 w = {r0[0], r1[0], r0[1], r1[1]}; OUT = *reinterpret_cast<bf16x8*>(&w); } while (0)
  PK4(p0, 0, pa0); PK4(p0, 8, pa1); PK4(p1, 0, pa2); PK4(p1, 8, pa3);
#undef PK4
}
__device__ __forceinline__ void qkt(f32x16& p0, f32x16& p1, const char* Ks, const bf16x8* qr, const char* qw, int r32, int hi) {
  p0 = f32x16{}; p1 = f32x16{};
#pragma unroll
  for (int d0 = 0; d0 < 12; ++d0) { int cb = (d0 * 16 + hi * 8) * 2;
    bf16x8 b0 = *reinterpret_cast<const bf16x8*>(Ks + KSWZ(r32, cb));
    bf16x8 b1 = *reinterpret_cast<const bf16x8*>(Ks + KSWZ(32 + r32, cb));
    const bf16x8 qf = (d0 < NQR) ? qr[d0 < NQR ? d0 : 0] : *reinterpret_cast<const bf16x8*>(qw + (d0 - NQR) * 1024);
    p0 = __builtin_amdgcn_mfma_f32_32x32x16_bf16(b0, qf, p0, 0, 0, 0);
    p1 = __builtin_amdgcn_mfma_f32_32x32x16_bf16(b1, qf, p1, 0, 0, 0); }
}
__device__ __forceinline__ int v_st(int k, int c) { const int kk = (k & ~0xC) | ((k & 4) << 1) | ((k & 8) >> 1); return ((kk >> 3) * 4 + (c >> 5)) * 512 + ((kk & 7) * 32 + (c & 31)) * 2; }
__device__ __forceinline__ int v_rd_base(int lane) { return ((lane & 3) << 3) | (((lane >> 2) & 3) << 6) | (((lane >> 4) & 1) << 5) | (((lane >> 5) & 1) << 8); }
constexpr int v_rd_off(int d0, int ks, int half) { return d0 * 512 + ks * 4096 + half * 2048; }
template <int OFF> __device__ __forceinline__ s16x4 tr_read(int vb) {
  s16x4 r; asm volatile("ds_read_b64_tr_b16 %0, %1 offset:%2" : "=&v"(r) : "v"(vb), "i"(OFF) : "memory"); return r;
}
template <int D0> __device__ __forceinline__ void pv_one(f32x16& od, int vb, bf16x8 pa0, bf16x8 pa1, bf16x8 pa2, bf16x8 pa3) {
  const s16x4 l0 = tr_read<v_rd_off(D0, 0, 0)>(vb), h0 = tr_read<v_rd_off(D0, 0, 1)>(vb), l1 = tr_read<v_rd_off(D0, 1, 0)>(vb), h1 = tr_read<v_rd_off(D0, 1, 1)>(vb);
  const s16x4 l2 = tr_read<v_rd_off(D0, 2, 0)>(vb), h2 = tr_read<v_rd_off(D0, 2, 1)>(vb), l3 = tr_read<v_rd_off(D0, 3, 0)>(vb), h3 = tr_read<v_rd_off(D0, 3, 1)>(vb);
  asm volatile("s_waitcnt lgkmcnt(0)" ::: "memory"); SBAR();
#define PK(L, H) (bf16x8){L[0], L[1], L[2], L[3], H[0], H[1], H[2], H[3]}
  od = __builtin_amdgcn_mfma_f32_32x32x16_bf16(pa0, PK(l0, h0), od, 0, 0, 0);
  od = __builtin_amdgcn_mfma_f32_32x32x16_bf16(pa1, PK(l1, h1), od, 0, 0, 0);
  od = __builtin_amdgcn_mfma_f32_32x32x16_bf16(pa2, PK(l2, h2), od, 0, 0, 0);
  od = __builtin_amdgcn_mfma_f32_32x32x16_bf16(pa3, PK(l3, h3), od, 0, 0, 0);
#undef PK
}
__device__ __forceinline__ void pv_d0(f32x16* o, int vb, bf16x8 pa0, bf16x8 pa1, bf16x8 pa2, bf16x8 pa3) {
  pv_one<0>(o[0], vb, pa0, pa1, pa2, pa3); pv_one<1>(o[1], vb, pa0, pa1, pa2, pa3); pv_one<2>(o[2], vb, pa0, pa1, pa2, pa3); pv_one<3>(o[3], vb, pa0, pa1, pa2, pa3);
}

__device__ __forceinline__ void attn_dense_body(const bf16* __restrict__ Qb, const bf16* __restrict__ Kh, const bf16* __restrict__ Vh, bf16* __restrict__ Ob, int seq, char* lds) {
  int tid_ = threadIdx.x; asm volatile("" : "+v"(tid_));
  const int tid = tid_, wid = tid >> 6, lane = tid & 63, r32 = lane & 31, hi = lane >> 5;
  char* V_lds = lds; char* K_lds = lds + 2 * SHM_V;
  float* ws = (float*)(lds + 2 * SHM_V + 2 * SHM_K) + wid * 64; float* li_l = ws; float* al_l = ws + 32;
  float m_reg = -1e30f, l_reg = 0; f32x16 o[4] = {}; bf16x8 qr[NQR];
  char* qw = lds + 2 * SHM_V + 2 * SHM_K + NW * 64 * 4 + wid * ((12 - NQR) * 1024) + lane * 16;
  const bf16* Qw = Qb + (long)(wid * QBLK + r32) * LDQ + hi * 8;
#pragma unroll
  for (int d0 = 0; d0 < NQR; ++d0) qr[d0] = *reinterpret_cast<const bf16x8*>(Qw + d0 * 16);
#pragma unroll
  for (int d0 = NQR; d0 < 12; ++d0) *reinterpret_cast<bf16x8*>(qw + (d0 - NQR) * 1024) = *reinterpret_cast<const bf16x8*>(Qw + d0 * 16);
  const int sr = tid >> 4, sc = (tid & 15) * 8, vst0 = v_st(sr, sc), vst1 = v_st(32 + sr, sc);
  int kg[3], kl[3];
#pragma unroll
  for (int i = 0; i < 3; ++i) { const int q = tid + 512 * i, kr_ = q / 24, kc = q % 24; kg[i] = kr_ * LDKK + kc * 8; kl[i] = KSWZ(kr_, kc * 16); }
  const int vb0 = (int)(uintptr_t)V_lds + v_rd_base(lane);
  bf16x8 vs0, vs1, ks0, ks1, ks2;
#define SLOAD(k0) do { vs0 = *(const bf16x8*)(&Vh[(long)((k0) + sr) * LDVV + sc]); vs1 = *(const bf16x8*)(&Vh[(long)((k0) + 32 + sr) * LDVV + sc]); \
    ks0 = *(const bf16x8*)(&Kh[(long)(k0) * LDKK + kg[0]]); ks1 = *(const bf16x8*)(&Kh[(long)(k0) * LDKK + kg[1]]); ks2 = *(const bf16x8*)(&Kh[(long)(k0) * LDKK + kg[2]]); } while (0)
#define SWRITE(b) do { *(bf16x8*)(V_lds + (b) * SHM_V + vst0) = vs0; *(bf16x8*)(V_lds + (b) * SHM_V + vst1) = vs1; \
    *(bf16x8*)(K_lds + (b) * SHM_K + kl[0]) = ks0; *(bf16x8*)(K_lds + (b) * SHM_K + kl[1]) = ks1; *(bf16x8*)(K_lds + (b) * SHM_K + kl[2]) = ks2; } while (0)
#define RESC(a) do { if (__any((a) < 1.f)) { if (hi == 0) al_l[r32] = (a); asm volatile("s_waitcnt lgkmcnt(0)" ::: "memory"); \
    _Pragma("unroll") for (int d = 0; d < 4; ++d) _Pragma("unroll") for (int r = 0; r < 16; ++r) o[d][r] *= al_l[crow(r, hi)]; } } while (0)
  f32x16 pA0, pA1, pB0, pB1; float mnA, mnB, alA, alB; bf16x8 pa0, pa1, pa2, pa3; const int NT = seq / KVBLK;
  SLOAD(0); asm volatile("s_waitcnt vmcnt(0)" ::: "memory"); SWRITE(0); __syncthreads();
  qkt(pA0, pA1, K_lds, qr, qw, r32, hi); partialSM(pA0, pA1, m_reg, mnA, alA);
  SLOAD(KVBLK);
  asm volatile("s_waitcnt vmcnt(0)" ::: "memory"); SWRITE(1); __syncthreads();
  for (int j = 1; j + 1 < NT; j += 2) {
    SBAR(); qkt(pB0, pB1, K_lds + SHM_K, qr, qw, r32, hi);
    finishSM(pA0, pA1, alA, l_reg, pa0, pa1, pa2, pa3); SBAR();
    SLOAD((j + 1) * KVBLK); SBAR();
    pv_d0(o, vb0, pa0, pa1, pa2, pa3); partialSM(pB0, pB1, m_reg, mnB, alB);
    __syncthreads(); asm volatile("s_waitcnt vmcnt(0)" ::: "memory"); SWRITE(0);
    RESC(alB); __syncthreads();
    SBAR(); qkt(pA0, pA1, K_lds, qr, qw, r32, hi);
    finishSM(pB0, pB1, alB, l_reg, pa0, pa1, pa2, pa3); SBAR();
    SLOAD((j + 2) * KVBLK); SBAR();
    pv_d0(o, vb0 + SHM_V, pa0, pa1, pa2, pa3); partialSM(pA0, pA1, m_reg, mnA, alA);
    __syncthreads(); asm volatile("s_waitcnt vmcnt(0)" ::: "memory"); SWRITE(1);
    RESC(alA); __syncthreads();
  }
  SBAR(); qkt(pB0, pB1, K_lds + SHM_K, qr, qw, r32, hi);
  finishSM(pA0, pA1, alA, l_reg, pa0, pa1, pa2, pa3); SBAR();
  pv_d0(o, vb0, pa0, pa1, pa2, pa3); partialSM(pB0, pB1, m_reg, mnB, alB);
  __syncthreads(); RESC(alB);
  finishSM(pB0, pB1, alB, l_reg, pa0, pa1, pa2, pa3); SBAR();
  pv_d0(o, vb0 + SHM_V, pa0, pa1, pa2, pa3);
  if (hi == 0) li_l[r32] = l_reg; asm volatile("s_waitcnt lgkmcnt(0)" ::: "memory");
  float rli[16];
#pragma unroll
  for (int r = 0; r < 16; ++r) rli[r] = __builtin_amdgcn_rcpf(li_l[crow(r, hi)]);
  bf16* Ow = Ob + (long)(wid * QBLK) * LDO;
#pragma unroll
  for (int r = 0; r < 16; ++r) { const int orow = crow(r, hi);
#pragma unroll
    for (int d0 = 0; d0 < 4; ++d0) { const float v = o[d0][r] * rli[r]; Ow[(long)orow * LDO + d0 * 32 + r32] = (bf16)(cvtpk(v, v) & 0xffffu); } }
  __syncthreads();
#undef SLOAD
#undef SWRITE
#undef RESC
}
#undef KSWZ
#undef SBAR
}
#ifndef MK_N_LAUNCHES
#define MK_N_LAUNCHES 1
#endif
constexpr int NWAVES = 8;
constexpr int N_PHASES = 10;
constexpr int N_LAUNCHES = MK_N_LAUNCHES;

constexpr size_t MiB = 1u << 20;
constexpr size_t WS_CTL = 0, CTL_ZERO_BYTES = 1 * MiB;
constexpr size_t WS_MODP = 1 * MiB;
constexpr size_t WS_MOD = WS_MODP + 640 * 1024;
constexpr size_t WS_TAB = WS_MOD + 160 * 1024;
constexpr size_t WS_SSQQ = 2 * MiB;
constexpr size_t WS_SSQK = WS_SSQQ + 64 * 1024;
constexpr size_t WS_KPW = 3 * MiB;
constexpr size_t WS_WIN = 8 * MiB;
constexpr size_t WS_WPOOL = 16 * MiB;
constexpr size_t WS_WUQ = 17 * MiB;
constexpr size_t WS_WUKV = 19 * MiB;
constexpr size_t WS_WOUT = 20 * MiB;
constexpr size_t WS_WUP = 28 * MiB;
constexpr size_t WS_WDOWN = 72 * MiB;
constexpr size_t WS_G = 94 * MiB;
constexpr size_t WS_H = 94 * MiB;
constexpr size_t WS_U = 126 * MiB;
constexpr size_t WS_PV = 142 * MiB;
constexpr size_t WS_CQ = 158 * MiB;
constexpr size_t WS_CKVN = 166 * MiB;
constexpr size_t WS_UP = 182 * MiB;
constexpr size_t WS_Q = 182 * MiB;
constexpr size_t WS_K = 206 * MiB;
constexpr size_t WS_V = 233 * MiB;
constexpr size_t WS_MIX = 251 * MiB;
constexpr size_t WS_END = 358 * MiB;
static_assert(WS_G + (size_t)NTOK * DFF * 2 <= WS_UP && WS_CKVN + (size_t)KVROWS * KVLORA * 2 <= WS_UP && WS_MIX + (size_t)NTOK * DM * 2 <= WS_END && WS_UP + (size_t)NTOK * 2 * DFF * 2 <= WS_END, "d_ws map");
constexpr int CW_BAR = 4096;

constexpr int RING_BYTES = 131072, SX_OFF = 139264  , MISC_OFF = SX_OFF + 4096, LDS_BYTES = 147456;
static_assert(att::SHM_ATTN <= SX_OFF && MISC_OFF + 256 <= LDS_BYTES, "LDS map");

#define GAS __attribute__((address_space(1)))
#define LAS __attribute__((address_space(3)))
typedef unsigned short bf16;
typedef unsigned v4u __attribute__((ext_vector_type(4)));
typedef unsigned v2u __attribute__((ext_vector_type(2)));
typedef float f32x4 __attribute__((ext_vector_type(4)));
typedef short bf16x8 __attribute__((ext_vector_type(8)));
#define LDS_WAIT() asm volatile("s_waitcnt lgkmcnt(0)" ::: "memory")
__device__ __forceinline__ unsigned f2bf(float f) { unsigned u = __builtin_bit_cast(unsigned, f); return (u + 0x7fffu + ((u >> 16) & 1u)) >> 16; }
__device__ __forceinline__ unsigned pk2(float lo, float hi) { return f2bf(lo) | (f2bf(hi) << 16); }
__device__ __forceinline__ float bflo(unsigned w) { return __builtin_bit_cast(float, w << 16); }
__device__ __forceinline__ float bfhi(unsigned w) { return __builtin_bit_cast(float, w & 0xffff0000u); }

#define XB_TMO      128
#define XB_XCNT(j)  (256  + 64 * (j))
#define XB_XSUB(j)  (1280 + 64 * (j))
#define XB_XGEN(j)  (2304 + 64 * (j))
#define XB_TOP      3328
#define XB_TOPGEN   3392
#define XCD_BAR_WORDS 3456
#define XB_SPIN_CAP (1u << 18)
__device__ __forceinline__ unsigned xb_ld(unsigned* p)              { return __hip_atomic_load(p, __ATOMIC_RELAXED, __HIP_MEMORY_SCOPE_AGENT); }
__device__ __forceinline__ unsigned xb_add(unsigned* p, unsigned v) { return __hip_atomic_fetch_add(p, v, __ATOMIC_RELAXED, __HIP_MEMORY_SCOPE_AGENT); }
__device__ __forceinline__ unsigned xb_xcc_id() { return (unsigned)__builtin_amdgcn_s_getreg((3 << 11) | 20) & 0xFu; }
#define XB_SPIN(cond, bar) do { unsigned _sp = 0; while (cond) { __builtin_amdgcn_s_sleep(1); \
    if ((++_sp & 255u) == 0u) { if (xb_ld(&(bar)[XB_TMO])) break; if (_sp > XB_SPIN_CAP) { atomicAdd(&(bar)[XB_TMO], 1u); break; } } } } while (0)
struct XcdBarrier { unsigned* bar; unsigned x; volatile LAS unsigned* st; };
__device__ __forceinline__ XcdBarrier xcd_barrier_post(unsigned* bar, volatile LAS unsigned* st) {
    XcdBarrier b; b.bar = bar; b.x = xb_xcc_id(); b.st = st;
    if (threadIdx.x == 0) (void)xb_add(&bar[XB_XCNT(b.x)], 1u);
    return b;
}
__device__ __forceinline__ void xcd_barrier_complete(unsigned* bar, unsigned x, unsigned& nloc, unsigned& nx) {
    const unsigned G = gridDim.x * gridDim.y * gridDim.z;
    unsigned sum, cnt, mine, sp = 0u;
    for (;;) {
        sum = 0u; cnt = 0u; mine = 0u;
#pragma unroll
        for (unsigned j = 0; j < 16; ++j) { const unsigned c = xb_ld(&bar[XB_XCNT(j)]); sum += c; cnt += (c > 0u) ? 1u : 0u; mine = (j == x) ? c : mine; }
        if (sum == G) break;
        __builtin_amdgcn_s_sleep(1);
        if ((++sp & 255u) == 0u) { if (xb_ld(&bar[XB_TMO])) break; if (sp > XB_SPIN_CAP) { atomicAdd(&bar[XB_TMO], 1u); break; } }
    }
    nloc = mine > 0u ? mine : 1u; nx = cnt > 0u ? cnt : 1u;
}
__device__ __forceinline__ void xcd_barrier(const XcdBarrier& b) {
    asm volatile("s_waitcnt vmcnt(0)" ::: "memory");
    __syncthreads();
    if (threadIdx.x == 0) {
        unsigned* bar = b.bar;
        __builtin_amdgcn_s_waitcnt(0);
        unsigned nloc = b.st[0], nx = b.st[1];
        if (nloc == 0u) { xcd_barrier_complete(bar, b.x, nloc, nx); b.st[0] = nloc; b.st[1] = nx; }
        const unsigned old = xb_add(&bar[XB_XSUB(b.x)], 1u);
        const unsigned gen = old / nloc;
        if (old + 1u == (gen + 1u) * nloc) {
            __builtin_amdgcn_fence(__ATOMIC_RELEASE, "agent");
            asm volatile("s_waitcnt vmcnt(0)" ::: "memory");
            const unsigned og = xb_add(&bar[XB_TOP], 1u);
            const unsigned tg = og / nx;
            if (og + 1u == (tg + 1u) * nx) xb_add(&bar[XB_TOPGEN], 1u);
            else XB_SPIN(xb_ld(&bar[XB_TOPGEN]) == tg, bar);
            __builtin_amdgcn_fence(__ATOMIC_ACQUIRE, "agent");
            xb_add(&bar[XB_XGEN(b.x)], 1u);
            asm volatile("s_waitcnt vmcnt(0)" ::: "memory");
        } else {
            XB_SPIN(xb_ld(&bar[XB_XGEN(b.x)]) == gen, bar);
            __builtin_amdgcn_fence(__ATOMIC_ACQUIRE, "agent");
            asm volatile("s_waitcnt vmcnt(0)" ::: "memory");
        }
    }
    __syncthreads();
}

struct Args {
    const float *x_prompt, *x_sample, *cache_ckv, *cache_kpe, *c, *c_ctx, *norm1_g, *norm2_g, *w_mod, *b_mod, *w_in, *w_pool, *pool_scale, *q_a_g, *w_uq, *kv_a_g, *w_ukv,
                *q_norm_g, *k_norm_g, *w_out, *w_up, *conv_w, *conv_b, *w_down;
    float* out; unsigned char* ws; int ph_lo, ph_hi, li, pad;
};
struct Frame {
    LAS unsigned char* lds; int tid, lane, wave, G, bid;
};
__device__ __forceinline__ float wave_sum(float v) {
#pragma unroll
    for (int o = 1; o < 64; o <<= 1) v += __shfl_xor(v, o);
    return v;
}
__device__ __forceinline__ float silu_f(float v) { return v / (1.0f + __expf(-v)); }

__device__ __forceinline__ void p0_transpose_item(const float* W, int N, int K, bf16* WT, int k0, int n0, int drow, const float* kscale, LAS float* scr, int lane) {
#pragma unroll 8
    for (int i = 0; i < 32; ++i) { const int kk = 2 * i + (lane >> 5); float v = W[(size_t)(k0 + kk) * N + n0 + (lane & 31)]; if (kscale) v *= kscale[k0 + kk]; scr[kk * 33 + (lane & 31)] = v; }
    LDS_WAIT(); asm volatile("" ::: "memory");
    const int c = lane & 7;
#pragma unroll
    for (int j = 0; j < 4; ++j) { const int n = (lane >> 3) + 8 * j; const LAS float* s = scr + (8 * c) * 33 + n;
        v4u o; o.x = pk2(s[0 * 33], s[1 * 33]); o.y = pk2(s[2 * 33], s[3 * 33]); o.z = pk2(s[4 * 33], s[5 * 33]); o.w = pk2(s[6 * 33], s[7 * 33]);
        *(GAS v4u*)(WT + (size_t)(drow + n) * K + k0 + 8 * c) = o; }
    LDS_WAIT(); asm volatile("" ::: "memory");
}
__device__ __forceinline__ void sincos_small(float x, float& s, float& c) {
    const double xd = (double)x; const double n = __builtin_rint(xd * 0.63661977236758134); const float r = (float)(xd - n * 1.5707963267948966); const int q = ((int)n) & 3;
    const float r2 = r * r;
    const float sp = r + r * r2 * (-1.6666667163e-01f + r2 * (8.3333337680e-03f + r2 * (-1.9841270114e-04f + r2 * 2.7557314297e-06f)));
    const float cp = 1.0f + r2 * (-0.5f + r2 * (4.1666667908e-02f + r2 * (-1.3888889225e-03f + r2 * (2.4801587642e-05f + r2 * -2.7557314297e-07f))));
    const float ss = (q & 1) ? cp : sp, cc = (q & 1) ? sp : cp;
    s = (q & 2) ? -ss : ss; c = ((q + 1) & 2) ? -cc : cc;
}

__device__ __forceinline__ void phase0(const Frame& F, const Args& a) {
    unsigned char* ws = a.ws;
    LAS float* sl = (LAS float*)F.lds;
    LAS float* red = sl + 3 * DM;
    for (int i = F.tid; i < 3 * DM; i += NWAVES * 64) { const int r = i / DM, k = i % DM; const float v = (r == 0) ? a.c_ctx[k] : a.c[(r - 1) * DM + k]; sl[i] = silu_f(v); }
    __syncthreads();
    float* MODP = (float*)(ws + WS_MODP);
    for (int task = F.bid; task < 768; task += F.G) {
        const int cb = task % 192, kq = task / 192, kbase = kq * 512 + F.wave * 64, rg = F.lane >> 4, cl = (F.lane & 15) * 4;
        f32x4 a0 = {0.f, 0.f, 0.f, 0.f}, a1 = a0, a2 = a0;
        const float* wp = a.w_mod + (size_t)(kbase + rg) * (NMOD * DM) + cb * 64 + cl;
#pragma unroll 4
        for (int i = 0; i < 16; ++i) { const f32x4 w = *(const f32x4*)(wp + (size_t)(4 * i) * (NMOD * DM)); const int k = kbase + 4 * i + rg;
            a0 += w * sl[k]; a1 += w * sl[DM + k]; a2 += w * sl[2 * DM + k]; }
#pragma unroll
        for (int j = 0; j < 4; ++j) { a0[j] += __shfl_xor(a0[j], 16); a0[j] += __shfl_xor(a0[j], 32); a1[j] += __shfl_xor(a1[j], 16); a1[j] += __shfl_xor(a1[j], 32); a2[j] += __shfl_xor(a2[j], 16); a2[j] += __shfl_xor(a2[j], 32); }
        if (rg == 0) { LAS float* rp = red + F.wave * 192 + cl; *(LAS f32x4*)rp = a0; *(LAS f32x4*)(rp + 64) = a1; *(LAS f32x4*)(rp + 128) = a2; }
        __syncthreads();
        if (F.tid < 192) { float s = 0.f;
#pragma unroll
            for (int w = 0; w < 8; ++w) s += red[w * 192 + F.tid];
            const int r = F.tid / 64, cc = F.tid % 64; MODP[((size_t)kq * 3 + r) * (NMOD * DM) + cb * 64 + cc] = s; }
        __syncthreads();
    }
    LAS float* scr = (LAS float*)(F.lds + 32768 + F.wave * 12288);
    const int gw = F.bid * NWAVES + F.wave, NGW = F.G * NWAVES;
    constexpr int I_IN = 32 * 58, I_POOL = 4 * 32, I_UQ = 8 * 48, I_UKV = 4 * 64, I_OUT = 32 * 64, I_UP = 32 * 352, I_DOWN = 88 * 64;
    constexpr int NITEMS = I_IN + I_POOL + I_UQ + I_UKV + I_OUT + I_UP + I_DOWN;
    bf16* WIN = (bf16*)(ws + WS_WIN); bf16* WPOOL = (bf16*)(ws + WS_WPOOL); bf16* WUQ = (bf16*)(ws + WS_WUQ); bf16* WUKV = (bf16*)(ws + WS_WUKV);
    bf16* WOUT = (bf16*)(ws + WS_WOUT); bf16* WUP = (bf16*)(ws + WS_WUP); bf16* WDOWN = (bf16*)(ws + WS_WDOWN);
    for (int it = gw; it < NITEMS; it += NGW) {
        int r = it;
        if (r < I_UP) { const int nb = r % 352, kb = r / 352, n0 = nb * 32; const int nn = n0 < DFF ? n0 : n0 - DFF; const int drow = (nn >> 7) * 256 + (nn & 127) + (n0 < DFF ? 0 : 128);
            p0_transpose_item(a.w_up, 2 * DFF, DM, WUP, kb * 64, n0, drow, nullptr, scr, F.lane); continue; } r -= I_UP;
        if (r < I_DOWN) { const int nb = r % 64, kb = r / 64; p0_transpose_item(a.w_down, DM, DFF, WDOWN, kb * 64, nb * 32, nb * 32, nullptr, scr, F.lane); continue; } r -= I_DOWN;
        if (r < I_OUT) { const int nb = r % 64, kb = r / 64; p0_transpose_item(a.w_out, DM, DM, WOUT, kb * 64, nb * 32, nb * 32, nullptr, scr, F.lane); continue; } r -= I_OUT;
        if (r < I_IN) { const int nb = r % 58, kb = r / 58; p0_transpose_item(a.w_in, INW, DM, WIN, kb * 64, nb * 32, nb * 32, nullptr, scr, F.lane); continue; } r -= I_IN;
        if (r < I_UQ) { const int nb = r % 48, kb = r / 48, n0 = nb * 32; const int drow = (n0 / DQK) * 256 + (n0 % DQK); p0_transpose_item(a.w_uq, NH * DQK, QLORA, WUQ, kb * 64, n0, drow, a.q_a_g, scr, F.lane); continue; } r -= I_UQ;
        if (r < I_UKV) { const int nb = r % 64, kb = r / 64; p0_transpose_item(a.w_ukv, NH * 256, KVLORA, WUKV, kb * 64, nb * 32, nb * 32, nullptr, scr, F.lane); continue; } r -= I_UKV;
        { const int g = r / 32, rr = r % 32, nb = rr % 8, kb = rr / 8; p0_transpose_item(a.w_pool + (size_t)g * 65536, 256, 256, WPOOL + (size_t)g * 65536, kb * 64, nb * 32, nb * 32, nullptr, scr, F.lane); }
    }
    const int gt = F.bid * (NWAVES * 64) + F.tid, NGT = F.G * NWAVES * 64;
    const v4u z4 = {0u, 0u, 0u, 0u};
    for (int i = gt; i < 49152 + 32768; i += NGT) {
        if (i < 49152) *(GAS v4u*)(WIN + (size_t)INW * DM + (size_t)i * 8) = z4;
        else { const int j = i - 49152, h = j / 4096, q = j % 4096; *(GAS v4u*)(WUQ + ((size_t)h * 256 + 192) * QLORA + (size_t)q * 8) = z4; }
    }
    float* TAB = (float*)(ws + WS_TAB);
    for (int i = gt; i < 1024; i += NGT) { const int pos = i >> 4, fi = i & 15; const float inv = powf(10000.0f, -(float)fi / 16.0f); float s, c; sincos_small((float)pos * inv, s, c); TAB[2 * i] = c; TAB[2 * i + 1] = s; }
    bf16* CKVN = (bf16*)(ws + WS_CKVN); float* KPW = (float*)(ws + WS_KPW); float* SSQK = (float*)(ws + WS_SSQK);
    for (int i = gw; i < LAT_B * PAST; i += NGW) { const int b = i / PAST, kr = NCTX + b * KVSEG + (i % PAST);
        const f32x4 v = *(const f32x4*)(a.cache_ckv + (size_t)i * KVLORA + F.lane * 4);
        v2u o; o.x = pk2(v[0], v[1]); o.y = pk2(v[2], v[3]); *(GAS v2u*)(CKVN + (size_t)kr * KVLORA + F.lane * 4) = o;
        const float kp = a.cache_kpe[(size_t)i * ROPED + F.lane]; KPW[(size_t)kr * ROPED + F.lane] = kp * a.k_norm_g[DNOPE + F.lane];
        const float ss = wave_sum(kp * kp); if (F.lane == 0) SSQK[kr] = ss; }
}

__device__ __forceinline__ void phase_norm(const Frame& F, const Args& a, int which) {
    unsigned char* ws = a.ws; const float* MODP = (const float*)(ws + WS_MODP); float* MOD = (float*)(ws + WS_MOD);
    LAS float* TA = (LAS float*)F.lds; LAS float* TS = TA + 3 * DM;
    const float* g = which ? a.norm2_g : a.norm1_g; const int csh = which ? 3 : 0, csc = which ? 4 : 1;
    for (int i = F.tid; i < 3 * DM; i += NWAVES * 64) { const int r = i / DM, c = i % DM; float sh, sc;
        if (which == 0) { const int i0 = r * (NMOD * DM) + csh * DM + c, i1 = r * (NMOD * DM) + csc * DM + c; sh = a.b_mod[csh * DM + c]; sc = a.b_mod[csc * DM + c];
#pragma unroll
            for (int q = 0; q < 4; ++q) { sh += MODP[(size_t)q * 3 * (NMOD * DM) + i0]; sc += MODP[(size_t)q * 3 * (NMOD * DM) + i1]; } }
        else { sh = MOD[r * (NMOD * DM) + csh * DM + c]; sc = MOD[r * (NMOD * DM) + csc * DM + c]; }
        TA[i] = g[c] * (1.0f + sc); TS[i] = sh; }
    if (which == 0) { const int gt = F.bid * (NWAVES * 64) + F.tid, NGT = F.G * NWAVES * 64;
        for (int i = gt; i < 3 * NMOD * DM; i += NGT) { float s = a.b_mod[i % (NMOD * DM)];
#pragma unroll
            for (int q = 0; q < 4; ++q) s += MODP[(size_t)q * 3 * (NMOD * DM) + i];
            MOD[i] = s; } }
    __syncthreads();
    bf16* H = (bf16*)(ws + WS_H); const int gw = F.bid * NWAVES + F.wave, NGW = F.G * NWAVES;
    for (int m = gw; m < NTOK; m += NGW) {
        const float* xrow = which ? a.out + (size_t)m * DM : (m < NCTX ? a.x_prompt + (size_t)m * DM : a.x_sample + (size_t)(m - NCTX) * DM);
        const int cond = m < NCTX ? 0 : 1 + ((m - NCTX) >> 11);
        const GAS f32x4* xr = (const GAS f32x4*)xrow + F.lane;
        f32x4 v[8]; float s = 0.f;
#pragma unroll
        for (int j = 0; j < 8; ++j) { v[j] = xr[64 * j]; s += (v[j][0] * v[j][0] + v[j][1] * v[j][1]) + (v[j][2] * v[j][2] + v[j][3] * v[j][3]); }
        const float rstd = 1.0f / sqrtf(wave_sum(s) * (1.0f / DM) + EPSN);
        GAS v2u* o8 = (GAS v2u*)(H + (size_t)m * DM) + F.lane;
#pragma unroll
        for (int j = 0; j < 8; ++j) { const int c = 256 * j + 4 * F.lane; const f32x4 ta = *(const LAS f32x4*)(TA + cond * DM + c), ts = *(const LAS f32x4*)(TS + cond * DM + c);
            const f32x4 h = v[j] * rstd * ta + ts; v2u w; w.x = pk2(h[0], h[1]); w.y = pk2(h[2], h[3]); o8[64 * j] = w; }
    }
}

__device__ __forceinline__ void phase_poolmix(const Frame& F, const Args& a) {
    unsigned char* ws = a.ws; const bf16* PV = (const bf16*)(ws + WS_PV); bf16* MIX = (bf16*)(ws + WS_MIX);
    const int gw = F.bid * NWAVES + F.wave, NGW = F.G * NWAVES;
    for (int it = gw; it < (NTOK / 2) * 4; it += NGW) {
        const int g = it & 3, rp = it >> 2, row = 2 * rp + (F.lane >> 5), col = g * 256 + (F.lane & 31) * 8, w = 2 << g;
        const int T = row < NCTX ? CTX_T : LAT_T, t = row < NCTX ? (row & (CTX_T - 1)) : ((row - NCTX) & (LAT_T - 1));
        const int lo = max(t - (w >> 1), 0), hi = min(t - (w >> 1) + w - 1, T - 1);
        float acc[8] = {0.f, 0.f, 0.f, 0.f, 0.f, 0.f, 0.f, 0.f};
        for (int j = 0; j < w; ++j) { const int tt = t - (w >> 1) + j; if (tt >= 0 && tt < T) { const v4u q = *(const GAS v4u*)(PV + (size_t)(row - t + tt) * POOLW + col);
            acc[0] += bflo(q.x); acc[1] += bfhi(q.x); acc[2] += bflo(q.y); acc[3] += bfhi(q.y); acc[4] += bflo(q.z); acc[5] += bfhi(q.z); acc[6] += bflo(q.w); acc[7] += bfhi(q.w); } }
        const v4u q = *(const GAS v4u*)(PV + (size_t)row * POOLW + col); const float ic = 1.0f / (float)(hi - lo + 1);
        const f32x4 s0 = *(const f32x4*)(a.pool_scale + col), s1 = *(const f32x4*)(a.pool_scale + col + 4);
        v4u o; o.x = pk2((acc[0] * ic - bflo(q.x)) * s0[0], (acc[1] * ic - bfhi(q.x)) * s0[1]); o.y = pk2((acc[2] * ic - bflo(q.y)) * s0[2], (acc[3] * ic - bfhi(q.y)) * s0[3]);
        o.z = pk2((acc[4] * ic - bflo(q.z)) * s1[0], (acc[5] * ic - bfhi(q.z)) * s1[1]); o.w = pk2((acc[6] * ic - bflo(q.w)) * s1[2], (acc[7] * ic - bfhi(q.w)) * s1[3]);
        *(GAS v4u*)(MIX + (size_t)row * DM + col) = o;
    }
}

__device__ __forceinline__ void phase_convgate(const Frame& F, const Args& a) {
    unsigned char* ws = a.ws; const bf16* UP = (const bf16*)(ws + WS_UP); bf16* Gb = (bf16*)(ws + WS_G);
    const int gw = F.bid * NWAVES + F.wave, NGW = F.G * NWAVES;
    for (int it = gw; it < (NTOK / 32) * 11; it += NGW) {
        const int strip = it % 11, blk = it / 11, c0 = strip * 512 + F.lane * 8, r0 = blk * 32;
        const int ua = (c0 >> 7) * 256 + (c0 & 127);
        const int T = r0 < NCTX ? CTX_T : LAT_T, t0 = r0 < NCTX ? (r0 & (CTX_T - 1)) : ((r0 - NCTX) & (LAT_T - 1));
        float wa[3][8], wb[3][8], ba[8], bb[8];
#pragma unroll
        for (int j = 0; j < 3; ++j)
#pragma unroll
            for (int e = 0; e < 8; ++e) { wa[j][e] = a.conv_w[(size_t)j * 2 * DFF + c0 + e]; wb[j][e] = a.conv_w[(size_t)j * 2 * DFF + DFF + c0 + e]; }
#pragma unroll
        for (int e = 0; e < 8; ++e) { ba[e] = a.conv_b[c0 + e]; bb[e] = a.conv_b[DFF + c0 + e]; }
        const v4u z4 = {0u, 0u, 0u, 0u};
        v4u pa = z4, pb = z4, ca, cb;
        if (t0 > 0) { pa = *(const GAS v4u*)(UP + (size_t)(r0 - 1) * (2 * DFF) + ua); pb = *(const GAS v4u*)(UP + (size_t)(r0 - 1) * (2 * DFF) + ua + 128); }
        ca = *(const GAS v4u*)(UP + (size_t)r0 * (2 * DFF) + ua); cb = *(const GAS v4u*)(UP + (size_t)r0 * (2 * DFF) + ua + 128);
        for (int i = 0; i < 32; ++i) {
            v4u na = z4, nb = z4;
            if (t0 + i + 1 < T) { na = *(const GAS v4u*)(UP + (size_t)(r0 + i + 1) * (2 * DFF) + ua); nb = *(const GAS v4u*)(UP + (size_t)(r0 + i + 1) * (2 * DFF) + ua + 128); }
            float g[8];
#define CG(e, PA, CA, NA, PB, CB, NB) { const float za = wa[0][e] * (PA) + wa[1][e] * (CA) + wa[2][e] * (NA) + ba[e]; const float zb = wb[0][e] * (PB) + wb[1][e] * (CB) + wb[2][e] * (NB) + bb[e]; g[e] = silu_f(za) * zb; }
            CG(0, bflo(pa.x), bflo(ca.x), bflo(na.x), bflo(pb.x), bflo(cb.x), bflo(nb.x)) CG(1, bfhi(pa.x), bfhi(ca.x), bfhi(na.x), bfhi(pb.x), bfhi(cb.x), bfhi(nb.x))
            CG(2, bflo(pa.y), bflo(ca.y), bflo(na.y), bflo(pb.y), bflo(cb.y), bflo(nb.y)) CG(3, bfhi(pa.y), bfhi(ca.y), bfhi(na.y), bfhi(pb.y), bfhi(cb.y), bfhi(nb.y))
            CG(4, bflo(pa.z), bflo(ca.z), bflo(na.z), bflo(pb.z), bflo(cb.z), bflo(nb.z)) CG(5, bfhi(pa.z), bfhi(ca.z), bfhi(na.z), bfhi(pb.z), bfhi(cb.z), bfhi(nb.z))
            CG(6, bflo(pa.w), bflo(ca.w), bflo(na.w), bflo(pb.w), bflo(cb.w), bflo(nb.w)) CG(7, bfhi(pa.w), bfhi(ca.w), bfhi(na.w), bfhi(pb.w), bfhi(cb.w), bfhi(nb.w))
#undef CG
            v4u o; o.x = pk2(g[0], g[1]); o.y = pk2(g[2], g[3]); o.z = pk2(g[4], g[5]); o.w = pk2(g[6], g[7]);
            *(GAS v4u*)(Gb + (size_t)(r0 + i) * DFF + c0) = o;
            pa = ca; pb = cb; ca = na; cb = nb;
        }
    }
}

__global__ void __launch_bounds__(NWAVES * 64, 2) mk_fwd(Args args) {
    extern __shared__ __attribute__((aligned(16))) unsigned char lds[];
    Frame F;
    F.lds = (LAS unsigned char*)lds; F.tid = threadIdx.x; F.lane = F.tid & 63; F.wave = __builtin_amdgcn_readfirstlane(F.tid >> 6); F.G = gridDim.x; F.bid = blockIdx.x;
    volatile LAS unsigned* MISC = (volatile LAS unsigned*)(F.lds + MISC_OFF);
    unsigned char* ws = args.ws;
    for (int u = F.tid; u < 64; u += NWAVES * 64) MISC[u] = 0u;
    __syncthreads();
    XcdBarrier bar; bar.bar = (unsigned*)(ws + WS_CTL) + CW_BAR; bar.x = 0; bar.st = nullptr;
    if (N_LAUNCHES == 1) bar = xcd_barrier_post((unsigned*)(ws + WS_CTL) + CW_BAR, MISC + 8);
    const int lo = args.ph_lo, hi = args.ph_hi;
#define IN(k) (lo <= (k) && (k) < hi)
#define SEAM(k) do { if (IN(k) && IN((k) + 1)) xcd_barrier(bar); } while (0)
    LAS float* sx = (LAS float*)(F.lds + SX_OFF);
    bf16* WIN = (bf16*)(ws + WS_WIN); bf16* WPOOL = (bf16*)(ws + WS_WPOOL); bf16* WUQ = (bf16*)(ws + WS_WUQ); bf16* WUKV = (bf16*)(ws + WS_WUKV);
    bf16* WOUT = (bf16*)(ws + WS_WOUT); bf16* WUP = (bf16*)(ws + WS_WUP); bf16* WDOWN = (bf16*)(ws + WS_WDOWN);
    bf16* Hb = (bf16*)(ws + WS_H); bf16* Ub = (bf16*)(ws + WS_U); bf16* PVb = (bf16*)(ws + WS_PV); bf16* CQb = (bf16*)(ws + WS_CQ); bf16* CKVN = (bf16*)(ws + WS_CKVN);
    bf16* Qb = (bf16*)(ws + WS_Q); bf16* Kb = (bf16*)(ws + WS_K); bf16* Vb = (bf16*)(ws + WS_V); bf16* MIX = (bf16*)(ws + WS_MIX); bf16* UPb = (bf16*)(ws + WS_UP); bf16* Gb = (bf16*)(ws + WS_G);
    float* MOD = (float*)(ws + WS_MOD); float* TAB = (float*)(ws + WS_TAB); float* SSQQ = (float*)(ws + WS_SSQQ); float* SSQK = (float*)(ws + WS_SSQK); float* KPW = (float*)(ws + WS_KPW);

    if (IN(0)) { phase0(F, args); } SEAM(0);
    if (IN(1)) { phase_norm(F, args, 0); } SEAM(1);
    if (IN(2)) {
        pg8::Gemm g{Hb, WIN}; pg8::StaticOrder S; S.init(NTOK, 2048, F.G, F.bid);
        epi::EpiIn E{Ub, CQb, CKVN, SSQQ, SSQK, KPW, args.out + (size_t)NTOK * DM, args.out + (size_t)NTOK * DM + (size_t)NCTX * KVLORA, args.kv_a_g, args.k_norm_g, TAB};
        pg8::gemm_phase<pg8::Geo<DM, DM, DM, 0>>(F.lds, sx, g, S, E);
    } SEAM(2);
    if (IN(3)) {
        { pg8::Gemm g{Ub, WPOOL}; pg8::StaticOrder S; S.init(NTOK, 1024, F.G, (F.bid + 128) % F.G); epi::EpiBf16<POOLW> E{PVb}; pg8::gemm_phase<pg8::Geo<POOLW, 256, 256, 512>>(F.lds, sx, g, S, E); }
        { pg8::Gemm g{CQb, WUQ}; pg8::StaticOrder S; S.init(NTOK, 2048, F.G, F.bid); epi::EpiQ E{Qb, SSQQ, args.q_norm_g, TAB}; pg8::gemm_phase<pg8::Geo<QLORA, QLORA, QLORA, 0>>(F.lds, sx, g, S, E); }
        { pg8::Gemm g{CKVN, WUKV}; pg8::StaticOrder S; S.init(KVROWS, 2048, F.G, F.bid); epi::EpiKV E{Kb, Vb, SSQK, KPW, args.k_norm_g}; pg8::gemm_phase<pg8::Geo<KVLORA, KVLORA, KVLORA, 0>>(F.lds, sx, g, S, E); }
    } SEAM(3);
    if (IN(4)) {
        phase_poolmix(F, args);
        for (int c = F.bid; c < 256; c += F.G) {
            const int h = c & 7;
            if (c < 128) { const int b = c >> 6, qb = (c >> 3) & 7; const size_t q0 = (size_t)NCTX + (size_t)b * LAT_T + (size_t)qb * 256, k0 = (size_t)NCTX + (size_t)b * KVSEG;
                att::attn_dense_body(Qb + q0 * (NH * DQK) + h * DQK, Kb + k0 * (NH * DQK) + h * DQK, Vb + k0 * (NH * DVH) + h * DVH, MIX + q0 * DM + POOLW + h * DVH, KVSEG, (char*)lds); }
            else { const int b = (c - 128) >> 3; const size_t q0 = (size_t)b * CTX_T;
                att::attn_dense_body(Qb + q0 * (NH * DQK) + h * DQK, Kb + q0 * (NH * DQK) + h * DQK, Vb + q0 * (NH * DVH) + h * DVH, MIX + q0 * DM + POOLW + h * DVH, CTX_T, (char*)lds); }
        }
    } SEAM(4);
    if (IN(5)) {
        pg8::Gemm g{MIX, WOUT}; pg8::StaticOrder S; S.init(NTOK, DM, F.G, F.bid);
        epi::EpiGateRes E{args.x_prompt, args.x_sample, args.out, MOD + 2 * DM}; pg8::gemm_phase<pg8::Geo<DM, DM, DM, 0>>(F.lds, sx, g, S, E);
    } SEAM(5);
    if (IN(6)) { phase_norm(F, args, 1); } SEAM(6);
    if (IN(7)) {
        pg8::Gemm g{Hb, WUP}; pg8::StaticOrder S; S.init(NTOK, 2 * DFF, F.G, F.bid); epi::EpiBf16<2 * DFF> E{UPb}; pg8::gemm_phase<pg8::Geo<DM, DM, DM, 0>>(F.lds, sx, g, S, E);
    } SEAM(7);
    if (IN(8)) { phase_convgate(F, args); } SEAM(8);
    if (IN(9)) {
        pg8::Gemm g{Gb, WDOWN}; pg8::StaticOrder S; S.init(NTOK, DM, F.G, F.bid);
        epi::EpiGateRes E{args.out, args.out + (size_t)NCTX * DM, args.out, MOD + 5 * DM}; pg8::gemm_phase<pg8::Geo<DFF, DFF, DFF, 0>>(F.lds, sx, g, S, E);
    }
#undef IN
#undef SEAM
}

extern "C" void kernel_launch(void* const* d_in, const int* in_sizes, int n_in, void* d_out, int out_size, void* d_ws, size_t ws_size, hipStream_t stream) {
    static int grid = 0;
    if (grid == 0) {
        if (n_in != 24 || in_sizes[0] != NCTX * DM || in_sizes[8] != DM * NMOD * DM || ws_size < WS_END) {
            fprintf(stderr, "kernel_launch: unexpected shapes: n_in %d in0 %d in8 %d ws %zu (need >= %zu); nothing launched\n", n_in, n_in > 0 ? in_sizes[0] : -1, n_in > 8 ? in_sizes[8] : -1, ws_size, (size_t)WS_END); grid = -1; return; }
        int dev = 0, cus = 0;
        if (hipGetDevice(&dev) != hipSuccess || hipDeviceGetAttribute(&cus, hipDeviceAttributeMultiprocessorCount, dev) != hipSuccess) { fprintf(stderr, "kernel_launch: device query failed\n"); grid = -1; return; }
        if (hipFuncSetAttribute((const void*)mk_fwd, hipFuncAttributeMaxDynamicSharedMemorySize, LDS_BYTES) != hipSuccess) { fprintf(stderr, "kernel_launch: hipFuncSetAttribute failed\n"); grid = -1; return; }
        (void)hipGetLastError();
        grid = cus;
    }
    if (grid < 0) return;
    if (hipMemsetAsync((char*)d_ws + WS_CTL, 0, CTL_ZERO_BYTES, stream) != hipSuccess) { fprintf(stderr, "kernel_launch: memset failed\n"); return; }
    Args a{};
    const float** ap = (const float**)&a;
    for (int i = 0; i < 24; ++i) ap[i] = (const float*)d_in[i];
    a.out = (float*)d_out; a.ws = (unsigned char*)d_ws;
    for (int li = 0; li < N_LAUNCHES; ++li) {
        a.ph_lo = (N_LAUNCHES == 1) ? 0 : li; a.ph_hi = (N_LAUNCHES == 1) ? N_PHASES : li + 1; a.li = li;
        hipLaunchKernelGGL(mk_fwd, dim3(grid), dim3(NWAVES * 64), LDS_BYTES, stream, a);
        const hipError_t le = hipPeekAtLastError();
        if (le != hipSuccess) { fprintf(stderr, "kernel_launch: launch %d failed: %s\n", li, hipGetErrorName(le)); break; }
    }
}
```

```cpp
#include <hip/hip_runtime.h>
#include <cstdio>
#include <cstdint>
namespace pg8 {
#define PG8_LAS __attribute__((address_space(3)))
typedef unsigned short bf16_t;
typedef short bf16x8 __attribute__((ext_vector_type(8)));
typedef float f32x4 __attribute__((ext_vector_type(4)));
typedef float f32x2 __attribute__((ext_vector_type(2)));
typedef unsigned u32x4 __attribute__((ext_vector_type(4)));
typedef unsigned u32x2 __attribute__((ext_vector_type(2)));
constexpr int BM = 256, BK = 64, HALF = 128, HTB = HALF * BK * 2  , STAGE_BYTES = 8 * HTB, NXCD = 8, WGM = 8;

__host__ __device__ __forceinline__ int lds_byte(int r, int c) { const int st = (r >> 4) * 2 + (c >> 5), rr = r & 15, cc = c & 31, ob = rr * 64 + cc * 2; return st * 1024 + (ob ^ (((ob >> 9) & 1) << 5)); }
__host__ __device__ __forceinline__ void stage_rc(int b, int& R, int& C) { const int st = b / 1024, sb = b % 1024, swz = sb ^ (((sb >> 9) & 1) << 5); R = (st >> 1) * 16 + swz / 64; C = (st & 1) * 32 + (swz % 64) / 2; }
__host__ __device__ __forceinline__ int perm32(int rho) { const int n = rho >> 4, i = rho & 15; return 8 * (i >> 2) + 4 * n + (i & 3); }

struct Unit { int pm, pn; };
struct Gemm { const bf16_t* A; const bf16_t* Bt; };
template <int LDA, int LDB, int KK, int APN> struct Geo { static constexpr int lda = LDA, ldb = LDB, K = KK, a_pn_bytes = APN; };

struct StaticOrder {
    int nM, nN, nwg, G, c;
    __host__ __device__ void init(int M, int N, int G_, int c_) { nM = M / BM; nN = N / BM; nwg = nM * nN; G = G_; c = c_; }
    __host__ __device__ bool next(int i, Unit& u) const {
        const long L = (long)i * G + c; if (L >= nwg) return false;
        int wgid = (int)L; { const int q = nwg / NXCD, r = nwg % NXCD, xcd = wgid % NXCD, off = wgid / NXCD; wgid = (xcd < r ? xcd * (q + 1) : r * (q + 1) + (xcd - r) * q) + off; }
        const int nig = WGM * nN, gid = wgid / nig, fm = gid * WGM, gsz = (nM - fm) < WGM ? (nM - fm) : WGM;
        u.pm = fm + ((wgid % nig) % gsz); u.pn = (wgid % nig) / gsz; return true;
    }
};

__device__ __forceinline__ unsigned cvt_pk_bf16(float lo, float hi) { unsigned r; asm volatile("v_cvt_pk_bf16_f32 %0, %1, %2" : "=v"(r) : "v"(lo), "v"(hi)); return r; }


template <class GEO, class Epi, class Sched>
__device__ __forceinline__ void gemm_phase(PG8_LAS unsigned char* lds, PG8_LAS float* sx, const Gemm g, const Sched& S, const Epi& E) {
    int tid_ = threadIdx.x; asm volatile("" : "+v"(tid_));
    const int tid = tid_, wid = __builtin_amdgcn_readfirstlane(tid >> 6), lane = tid & 63, wr = wid >> 2, wc = wid & 3, fr = lane & 15, fq = lane >> 4;
    constexpr int K = GEO::K, nt = K / BK;
    unsigned voffA[2], voffB[2];
#pragma unroll
    for (int i = 0; i < 2; ++i) { int R, C; stage_rc(tid * 16 + i * 8192, R, C); const int Rb = Epi::PERM ? ((R & ~31) + perm32(R & 31)) : R;
        voffA[i] = (unsigned)(R * GEO::lda + C) * 2u; voffB[i] = (unsigned)(Rb * GEO::ldb + C) * 2u; }
    const size_t kstep = (size_t)(BK * 2);
    const size_t hstepA = (size_t)HALF * GEO::lda * 2, hstepB = (size_t)HALF * GEO::ldb * 2;
    const size_t tstepA = 2 * hstepA, tstepB = 2 * hstepB;
    const unsigned ldsw = (unsigned)wid * 1024u;
    const int aoff = lds_byte(wr * 64 + fr, fq * 8), boff = lds_byte(wc * 32 + fr, fq * 8);
#define PG8_SA(b, h) (((b) * 2 + (h)) * HTB)
#define PG8_SB(b, h) ((4 + (b) * 2 + (h)) * HTB)
#define PG8_STAGE(bufoff, gbase, voff) do { _Pragma("unroll") for (int _i = 0; _i < 2; ++_i) \
        __builtin_amdgcn_global_load_lds((const unsigned*)((const char*)(gbase) + (voff)[_i]), (PG8_LAS unsigned*)(lds + (bufoff) + ldsw + _i * 8192), 16, 0, 0); } while (0)
#define PG8_LDA(dst, b, h) do { _Pragma("unroll") for (int m = 0; m < 4; ++m) _Pragma("unroll") for (int k = 0; k < 2; ++k) dst[m][k] = *(const PG8_LAS bf16x8*)(lds + PG8_SA(b, h) + aoff + m * 2048 + k * 1024); } while (0)
#define PG8_LDB(dst, b, h) do { _Pragma("unroll") for (int n = 0; n < 2; ++n) _Pragma("unroll") for (int k = 0; k < 2; ++k) dst[n][k] = *(const PG8_LAS bf16x8*)(lds + PG8_SB(b, h) + boff + n * 2048 + k * 1024); } while (0)
#define PG8_MMA(ai, bj, At, Bt) do { __builtin_amdgcn_s_setprio(1); _Pragma("unroll") for (int m = 0; m < 4; ++m) _Pragma("unroll") for (int n = 0; n < 2; ++n) _Pragma("unroll") for (int k = 0; k < 2; ++k) \
        acc[ai][bj][m][n] = __builtin_amdgcn_mfma_f32_16x16x32_bf16(Bt[n][k], At[m][k], acc[ai][bj][m][n], 0, 0, 0); __builtin_amdgcn_s_setprio(0); } while (0)
#define PG8_WAIT_V(n) asm volatile("s_waitcnt vmcnt(" #n ")" ::: "memory")
#define PG8_WAIT_L(n) asm volatile("s_waitcnt lgkmcnt(" #n ")" ::: "memory")
#define PG8_BAR __builtin_amdgcn_s_barrier()
#define PG8_SCHED __builtin_amdgcn_sched_barrier(0)
    Unit cur, nxt; int ui = 0;
    if (!S.next(0, cur)) return;
    f32x4 acc[2][2][4][2];
#pragma unroll
    for (int a = 0; a < 2; ++a)
#pragma unroll
        for (int b = 0; b < 2; ++b)
#pragma unroll
            for (int m = 0; m < 4; ++m)
#pragma unroll
                for (int n = 0; n < 2; ++n) acc[a][b][m][n] = (f32x4){0.f, 0.f, 0.f, 0.f};
    bf16x8 At[4][2], B0[2][2], B1[2][2];
    const char* cA = (const char*)g.A + (size_t)cur.pm * tstepA + (size_t)cur.pn * GEO::a_pn_bytes; const char* cB = (const char*)g.Bt + (size_t)cur.pn * tstepB;
    PG8_STAGE(PG8_SB(0, 0), cB, voffB); PG8_STAGE(PG8_SB(0, 1), cB + hstepB, voffB); PG8_STAGE(PG8_SA(0, 0), cA, voffA); PG8_STAGE(PG8_SA(0, 1), cA + hstepA, voffA);
    if (wr == 1) PG8_BAR;
    PG8_WAIT_V(2); PG8_BAR;
    PG8_STAGE(PG8_SB(1, 0), cB + kstep, voffB); PG8_STAGE(PG8_SA(1, 0), cA + kstep, voffA); PG8_STAGE(PG8_SB(1, 1), cB + hstepB + kstep, voffB);
    PG8_WAIT_V(6); PG8_BAR;
    for (;;) {
        const bool has_next = S.next(ui + 1, nxt);
        const char* nA = has_next ? (const char*)g.A + (size_t)nxt.pm * tstepA + (size_t)nxt.pn * GEO::a_pn_bytes : cA; const char* nB = has_next ? (const char*)g.Bt + (size_t)nxt.pn * tstepB : cB;
#pragma unroll 1
        for (int t = 0; t < nt; t += 2) {
            const bool last = (t == nt - 2);
            const char* a1 = cA + (size_t)(t + 1) * kstep;
            const char* a2 = last ? nA : cA + (size_t)(t + 2) * kstep; const char* b2 = last ? nB : cB + (size_t)(t + 2) * kstep;
            const char* a3 = a2 + kstep; const char* b3 = b2 + kstep;
            PG8_LDB(B0, 0, 0); PG8_LDB(B1, 0, 1); PG8_SCHED; PG8_LDA(At, 0, 0); PG8_STAGE(PG8_SA(1, 1), a1 + hstepA, voffA);
            PG8_WAIT_V(8); PG8_WAIT_L(0); PG8_BAR; PG8_MMA(0, 0, At, B0); PG8_MMA(0, 1, At, B1); PG8_BAR; PG8_SCHED;
            PG8_LDA(At, 0, 1); PG8_STAGE(PG8_SB(0, 0), b2, voffB); PG8_STAGE(PG8_SB(0, 1), b2 + hstepB, voffB); PG8_STAGE(PG8_SA(0, 0), a2, voffA);
            PG8_WAIT_V(8); PG8_WAIT_L(0); PG8_BAR; PG8_MMA(1, 0, At, B0); PG8_MMA(1, 1, At, B1); PG8_BAR; PG8_SCHED;
            PG8_LDB(B0, 1, 0); PG8_LDB(B1, 1, 1); PG8_SCHED; PG8_LDA(At, 1, 0); PG8_STAGE(PG8_SA(0, 1), a2 + hstepA, voffA);
            PG8_WAIT_V(8); PG8_WAIT_L(0); PG8_BAR; PG8_MMA(0, 0, At, B0); PG8_MMA(0, 1, At, B1); PG8_BAR; PG8_SCHED;
            PG8_LDA(At, 1, 1); PG8_STAGE(PG8_SB(1, 0), b3, voffB); PG8_STAGE(PG8_SB(1, 1), b3 + hstepB, voffB); PG8_STAGE(PG8_SA(1, 0), a3, voffA);
            PG8_WAIT_V(8); PG8_WAIT_L(0); PG8_BAR; PG8_MMA(1, 0, At, B0); PG8_MMA(1, 1, At, B1); PG8_BAR; PG8_SCHED;
        }
        if (wr == 0) PG8_BAR;
        { int fr_ = fr, fq_ = fq; asm volatile("" : "+v"(fr_), "+v"(fq_));
          E(acc, cur, wr, wc, fr_, fq_, sx); }
        if (!has_next) break;
#pragma unroll
        for (int a = 0; a < 2; ++a)
#pragma unroll
            for (int b = 0; b < 2; ++b)
#pragma unroll
                for (int m = 0; m < 4; ++m)
#pragma unroll
                    for (int n = 0; n < 2; ++n) acc[a][b][m][n] = (f32x4){0.f, 0.f, 0.f, 0.f};
        cur = nxt; cA = nA; cB = nB; ++ui;
        if (wr == 1) PG8_BAR;
    }
    PG8_WAIT_V(0);
    PG8_BAR;
#undef PG8_SA
#undef PG8_SB
#undef PG8_STAGE
#undef PG8_LDA
#undef PG8_LDB
#undef PG8_MMA
}
}
constexpr int DM = 2048, NTOK = 8192, NCTX = 4096, LAT_T = 2048, LAT_B = 2, CTX_T = 256, PAST = 512;
constexpr int KVSEG = PAST + LAT_T;
constexpr int KVROWS = NCTX + LAT_B * KVSEG;
constexpr int POOLW = 1024, QLORA = 512, KVLORA = 256, ROPED = 64, INW = 1856, NH = 8, DQK = 192, DNOPE = 128, DVH = 128, DFF = 5632, NMOD = 6;
constexpr float EPSN = 1e-6f;

__device__ __forceinline__ int kvrow_of(int row) { return row < NCTX ? row : NCTX + ((row - NCTX) >> 11) * KVSEG + PAST + ((row - NCTX) & (LAT_T - 1)); }

namespace epi {
using namespace pg8;
#define EPI_LAS __attribute__((address_space(3)))
__device__ __forceinline__ float fq_sum(float s) { s += __shfl_xor(s, 16); s += __shfl_xor(s, 32); return s; }
__device__ __forceinline__ void lds_bar() { asm volatile("s_waitcnt lgkmcnt(0)" ::: "memory"); __builtin_amdgcn_s_barrier(); asm volatile("" ::: "memory"); }
__device__ __forceinline__ u32x4 pack8(const f32x4 a, const f32x4 b) { u32x4 w; w.x = cvt_pk_bf16(a[0], a[1]); w.y = cvt_pk_bf16(a[2], a[3]); w.z = cvt_pk_bf16(b[0], b[1]); w.w = cvt_pk_bf16(b[2], b[3]); return w; }
__device__ __forceinline__ float sq4(const f32x4 v) { return (v[0] * v[0] + v[1] * v[1]) + (v[2] * v[2] + v[3] * v[3]); }

template <int ldc> struct EpiBf16 {
    static constexpr bool PERM = true;
    bf16_t* O;
    __device__ __forceinline__ void operator()(const f32x4 (&acc)[2][2][4][2], const Unit& u, int wr, int wc, int fr, int fq, EPI_LAS float*) const {
        const int row0 = u.pm * BM + wr * 64 + fr, col0 = u.pn * BM + wc * 32 + 8 * fq;
#pragma unroll
        for (int ai = 0; ai < 2; ++ai)
#pragma unroll
            for (int m = 0; m < 4; ++m) { bf16_t* rowp = O + (size_t)(row0 + ai * HALF + m * 16) * ldc + col0;
#pragma unroll
                for (int bj = 0; bj < 2; ++bj) *(u32x4*)(rowp + bj * HALF) = pack8(acc[ai][bj][m][0], acc[ai][bj][m][1]); }
    }
};

__device__ __forceinline__ f32x4 rope4(const f32x4 w, const float* tab, int pos, int fq, int n) {
    f32x4 p; p[0] = __shfl_xor(w[0], 32); p[1] = __shfl_xor(w[1], 32); p[2] = __shfl_xor(w[2], 32); p[3] = __shfl_xor(w[3], 32);
    const float* tp = tab + ((size_t)pos * 16 + 8 * (fq & 1) + 4 * n) * 2;
    const f32x4 c0 = *(const f32x4*)tp, c1 = *(const f32x4*)(tp + 4);
    const float sg = (fq < 2) ? -1.f : 1.f;
    f32x4 o; o[0] = w[0] * c0[0] + sg * p[0] * c0[1]; o[1] = w[1] * c0[2] + sg * p[1] * c0[3]; o[2] = w[2] * c1[0] + sg * p[2] * c1[1]; o[3] = w[3] * c1[2] + sg * p[3] * c1[3];
    return o;
}

struct EpiIn {
    static constexpr bool PERM = true;
    bf16_t* U; bf16_t* CQ; bf16_t* CKVN; float* SSQQ; float* SSQK; float* KPW; float* out_ckv; float* out_kpe;
    const float* kv_a_g; const float* k_norm_g; const float* tab;
    __device__ __forceinline__ void operator()(const f32x4 (&acc)[2][2][4][2], const Unit& u, int wr, int wc, int fr, int fq, EPI_LAS float* part) const {
        const int pn = u.pn, rl0 = wr * 64 + fr, row0 = u.pm * BM + rl0, cl0 = wc * 32 + 8 * fq;
        if (pn < 4) {
#pragma unroll
            for (int ai = 0; ai < 2; ++ai)
#pragma unroll
                for (int m = 0; m < 4; ++m) { bf16_t* rowp = U + (size_t)(row0 + ai * HALF + m * 16) * POOLW + pn * BM + cl0;
#pragma unroll
                    for (int bj = 0; bj < 2; ++bj) *(u32x4*)(rowp + bj * HALF) = pack8(acc[ai][bj][m][0], acc[ai][bj][m][1]); }
            return;
        }
        const bool kpe_tile = (pn == 7);
#pragma unroll
        for (int ai = 0; ai < 2; ++ai)
#pragma unroll
            for (int m = 0; m < 4; ++m) {
                float s = sq4(acc[ai][0][m][0]) + sq4(acc[ai][0][m][1]);
                if (kpe_tile) { if (wc >= 2) s = 0.f; } else s += sq4(acc[ai][1][m][0]) + sq4(acc[ai][1][m][1]);
                s = fq_sum(s);
                if (fq == 0) part[(ai * HALF + rl0 + m * 16) * 4 + wc] = s;
            }
        lds_bar();
        if (pn < 6) {
#pragma unroll
            for (int ai = 0; ai < 2; ++ai)
#pragma unroll
                for (int m = 0; m < 4; ++m) { const int rl = ai * HALF + rl0 + m * 16, row = u.pm * BM + rl;
                    bf16_t* rowp = CQ + (size_t)row * QLORA + (pn - 4) * BM + cl0;
#pragma unroll
                    for (int bj = 0; bj < 2; ++bj) *(u32x4*)(rowp + bj * HALF) = pack8(acc[ai][bj][m][0], acc[ai][bj][m][1]);
                    if (wc == 0 && fq == 0) { const f32x4 p4 = *(const EPI_LAS f32x4*)(part + rl * 4); SSQQ[(pn - 4) * NTOK + row] = (p4[0] + p4[1]) + (p4[2] + p4[3]); } }
        } else if (pn == 6) {
            f32x4 gv[2][2];
#pragma unroll
            for (int bj = 0; bj < 2; ++bj)
#pragma unroll
                for (int n = 0; n < 2; ++n) gv[bj][n] = *(const f32x4*)(kv_a_g + bj * HALF + cl0 + 4 * n);
#pragma unroll
            for (int ai = 0; ai < 2; ++ai)
#pragma unroll
                for (int m = 0; m < 4; ++m) { const int rl = ai * HALF + rl0 + m * 16, row = u.pm * BM + rl;
                    const f32x4 p4 = *(const EPI_LAS f32x4*)(part + rl * 4); const float rstd = 1.0f / sqrtf(((p4[0] + p4[1]) + (p4[2] + p4[3])) * (1.0f / KVLORA) + EPSN);
                    bf16_t* rowp = CKVN + (size_t)kvrow_of(row) * KVLORA + cl0;
#pragma unroll
                    for (int bj = 0; bj < 2; ++bj) { const f32x4 v0 = acc[ai][bj][m][0] * rstd * gv[bj][0], v1 = acc[ai][bj][m][1] * rstd * gv[bj][1];
                        *(u32x4*)(rowp + bj * HALF) = pack8(v0, v1);
                        if (row < NCTX) { float* op = out_ckv + (size_t)row * KVLORA + bj * HALF + cl0; *(f32x4*)op = v0; *(f32x4*)(op + 4) = v1; } } }
        } else {
            const bool lat = (u.pm >= NCTX / BM);
            if (wc < 2) {
                f32x4 gv[2];
#pragma unroll
                for (int n = 0; n < 2; ++n) gv[n] = *(const f32x4*)(k_norm_g + DNOPE + cl0 + 4 * n);
#pragma unroll
                for (int ai = 0; ai < 2; ++ai)
#pragma unroll
                    for (int m = 0; m < 4; ++m) { const int rl = ai * HALF + rl0 + m * 16, row = u.pm * BM + rl, kr = kvrow_of(row);
#pragma unroll
                        for (int n = 0; n < 2; ++n) { f32x4 w = acc[ai][0][m][n] * gv[n];
                            if (lat) { const int t = (row - NCTX) & (LAT_T - 1); w = rope4(w, tab, wc == 0 ? (t >> 6) : (t & 63), fq, n); }
                            else *(f32x4*)(out_kpe + (size_t)row * ROPED + cl0 + 4 * n) = acc[ai][0][m][n];
                            *(f32x4*)(KPW + (size_t)kr * ROPED + cl0 + 4 * n) = w; }
                        if (wc == 0 && fq == 0) { const f32x4 p4 = *(const EPI_LAS f32x4*)(part + rl * 4); SSQK[kr] = (p4[0] + p4[1]) + (p4[2] + p4[3]); } }
            }
        }
    }
};

struct EpiQ {
    static constexpr bool PERM = true;
    bf16_t* Q; const float* SSQQ; const float* q_norm_g; const float* tab;
    __device__ __forceinline__ void operator()(f32x4 (&acc)[2][2][4][2], const Unit& u, int wr, int wc, int fr, int fq, EPI_LAS float* part) const {
        const int h = u.pn, rl0 = wr * 64 + fr, cl0 = wc * 32 + 8 * fq; const bool lat = (u.pm >= NCTX / BM), v1ok = (wc < 2);
#pragma unroll
        for (int ai = 0; ai < 2; ++ai)
#pragma unroll
            for (int m = 0; m < 4; ++m) { const int rl = ai * HALF + rl0 + m * 16, row = u.pm * BM + rl;
                const float rc = 1.0f / sqrtf((SSQQ[row] + SSQQ[NTOK + row]) * (1.0f / QLORA) + EPSN);
#pragma unroll
                for (int bj = 0; bj < 2; ++bj)
#pragma unroll
                    for (int n = 0; n < 2; ++n) acc[ai][bj][m][n] = acc[ai][bj][m][n] * rc;
                float s = sq4(acc[ai][0][m][0]) + sq4(acc[ai][0][m][1]);
                if (v1ok) s += sq4(acc[ai][1][m][0]) + sq4(acc[ai][1][m][1]);
                s = fq_sum(s);
                if (fq == 0) part[rl * 4 + wc] = s;
            }
        lds_bar();
        f32x4 gv[2][2];
#pragma unroll
        for (int bj = 0; bj < 2; ++bj)
#pragma unroll
            for (int n = 0; n < 2; ++n) gv[bj][n] = (bj == 0 || v1ok) ? *(const f32x4*)(q_norm_g + bj * HALF + cl0 + 4 * n) : (f32x4){0.f, 0.f, 0.f, 0.f};
#pragma unroll
        for (int ai = 0; ai < 2; ++ai)
#pragma unroll
            for (int m = 0; m < 4; ++m) { const int rl = ai * HALF + rl0 + m * 16, row = u.pm * BM + rl;
                const f32x4 p4 = *(const EPI_LAS f32x4*)(part + rl * 4); const float rn = 1.0f / sqrtf(((p4[0] + p4[1]) + (p4[2] + p4[3])) * (1.0f / DQK) + EPSN);
                bf16_t* rowp = Q + (size_t)row * (NH * DQK) + h * DQK + cl0;
                *(u32x4*)rowp = pack8(acc[ai][0][m][0] * rn * gv[0][0], acc[ai][0][m][1] * rn * gv[0][1]);
                if (v1ok) { f32x4 w0 = acc[ai][1][m][0] * rn * gv[1][0], w1 = acc[ai][1][m][1] * rn * gv[1][1];
                    if (lat) { const int t = (row - NCTX) & (LAT_T - 1), pos = (wc == 0) ? (t >> 6) : (t & 63); w0 = rope4(w0, tab, pos, fq, 0); w1 = rope4(w1, tab, pos, fq, 1); }
                    *(u32x4*)(rowp + HALF) = pack8(w0, w1); } }
    }
};

#define EPI_PIN(x) asm volatile("" : "+v"(x))
#define EPI_FENCE() asm volatile("" ::: "memory")
struct EpiKV {
    static constexpr bool PERM = true;
    bf16_t* Kb; bf16_t* Vb; const float* SSQK; const float* KPW; const float* k_norm_g;
    __device__ __forceinline__ void operator()(const f32x4 (&acc)[2][2][4][2], const Unit& u, int wr, int wc, int fr, int fq, EPI_LAS float* part) const {
        const int h = u.pn, rl0 = wr * 64 + fr, cl0 = wc * 32 + 8 * fq, e = 16 * wc + 4 * fq;
        float sk[4]; f32x4 kw[4];
        int kr0 = u.pm * BM + rl0; EPI_PIN(kr0);
#pragma unroll
        for (int m = 0; m < 4; ++m) { const int kr = kr0 + m * 16; sk[m] = SSQK[kr]; kw[m] = *(const f32x4*)(KPW + (size_t)kr * ROPED + e); }
#pragma unroll
        for (int ai = 0; ai < 2; ++ai)
#pragma unroll
            for (int m = 0; m < 4; ++m) { float s = sq4(acc[ai][0][m][0]) + sq4(acc[ai][0][m][1]); s = fq_sum(s); if (fq == 0) part[(ai * HALF + rl0 + m * 16) * 4 + wc] = s; }
        lds_bar();
        f32x4 gv[2];
#pragma unroll
        for (int n = 0; n < 2; ++n) gv[n] = *(const f32x4*)(k_norm_g + cl0 + 4 * n);
#pragma unroll
        for (int ai = 0; ai < 2; ++ai) {
            if (ai == 1) { int kr1 = u.pm * BM + HALF + rl0; EPI_PIN(kr1);
#pragma unroll
                for (int m = 0; m < 4; ++m) { const int kr = kr1 + m * 16; sk[m] = SSQK[kr]; kw[m] = *(const f32x4*)(KPW + (size_t)kr * ROPED + e); } }
#pragma unroll
            for (int m = 0; m < 4; ++m) { const int rl = ai * HALF + rl0 + m * 16; int kr = u.pm * BM + rl; EPI_PIN(kr);
                const f32x4 p4 = *(const EPI_LAS f32x4*)(part + rl * 4); const float rk = 1.0f / sqrtf((((p4[0] + p4[1]) + (p4[2] + p4[3])) + sk[m]) * (1.0f / DQK) + EPSN);
                bf16_t* kp = Kb + (size_t)kr * (NH * DQK) + h * DQK;
                *(u32x4*)(kp + cl0) = pack8(acc[ai][0][m][0] * rk * gv[0], acc[ai][0][m][1] * rk * gv[1]);
                *(u32x4*)(Vb + (size_t)kr * (NH * DVH) + h * DVH + cl0) = pack8(acc[ai][1][m][0], acc[ai][1][m][1]);
                const f32x4 kv = kw[m] * rk;
                u32x2 w; w.x = cvt_pk_bf16(kv[0], kv[1]); w.y = cvt_pk_bf16(kv[2], kv[3]); *(u32x2*)(kp + DNOPE + e) = w;
                EPI_FENCE(); }
        }
    }
};

template <int CTRL> __device__ __forceinline__ float dpp_upd(float old, float src) {
    return __builtin_bit_cast(float, __builtin_amdgcn_update_dpp(__builtin_bit_cast(int, old), __builtin_bit_cast(int, src), CTRL, 0xf, 0xf, false)); }
struct EpiUpConv {
    static constexpr bool PERM = true;
    bf16_t* G; float* EDGE; const float* conv_w; const float* conv_b;
    __device__ __forceinline__ void operator()(const f32x4 (&acc)[2][2][4][2], const Unit& u, int wr, int wc, int fr, int fq, EPI_LAS float* E) const {
        const int cl0 = wc * 32 + 8 * fq;
#pragma unroll
        for (int ai = 0; ai < 2; ++ai) { const int rb = 2 * ai + wr;
            if (fr == 0) {
#pragma unroll
                for (int ab = 0; ab < 2; ++ab)
#pragma unroll
                    for (int n = 0; n < 2; ++n) *(EPI_LAS f32x4*)(E + ((rb * 2 + 0) * 2 + ab) * 128 + cl0 + 4 * n) = acc[ai][ab][0][n]; }
            if (fr == 15) {
#pragma unroll
                for (int ab = 0; ab < 2; ++ab)
#pragma unroll
                    for (int n = 0; n < 2; ++n) *(EPI_LAS f32x4*)(E + ((rb * 2 + 1) * 2 + ab) * 128 + cl0 + 4 * n) = acc[ai][ab][3][n]; } }
        lds_bar();
        const bool lat = (u.pm >= NCTX / BM);
#pragma unroll
        for (int n = 0; n < 2; ++n) {
            int c = u.pn * HALF + cl0 + 4 * n; EPI_PIN(c);
            f32x4 w[2][3], bs[2];
#pragma unroll
            for (int ab = 0; ab < 2; ++ab) { bs[ab] = *(const f32x4*)(conv_b + ab * DFF + c);
#pragma unroll
                for (int k = 0; k < 3; ++k) w[ab][k] = *(const f32x4*)(conv_w + (size_t)k * (2 * DFF) + ab * DFF + c); }
#pragma unroll
            for (int ai = 0; ai < 2; ++ai) { const int rb = 2 * ai + wr;
                f32x4 z[2][4];
#pragma unroll
                for (int ab = 0; ab < 2; ++ab) {
                    f32x4 pe = {0.f, 0.f, 0.f, 0.f}, ne = pe;
                    if (rb > 0) pe = *(const EPI_LAS f32x4*)(E + (((rb - 1) * 2 + 1) * 2 + ab) * 128 + cl0 + 4 * n);
                    if (rb < 3) ne = *(const EPI_LAS f32x4*)(E + (((rb + 1) * 2 + 0) * 2 + ab) * 128 + cl0 + 4 * n);
                    f32x4 mir[4];
#pragma unroll
                    for (int m = 0; m < 4; ++m)
#pragma unroll
                        for (int j = 0; j < 4; ++j) mir[m][j] = dpp_upd<0x140>(0.f, acc[ai][ab][m][n][j]);
#pragma unroll
                    for (int m = 0; m < 4; ++m)
#pragma unroll
                        for (int j = 0; j < 4; ++j) { const float v = acc[ai][ab][m][n][j];
                            const float prev = dpp_upd<0x111>(m > 0 ? mir[m - 1][j] : pe[j], v);
                            const float next = dpp_upd<0x101>(m < 3 ? mir[m + 1][j] : ne[j], v);
                            z[ab][m][j] = w[ab][0][j] * prev + w[ab][1][j] * v + w[ab][2][j] * next + bs[ab][j]; }
                }
#pragma unroll
                for (int m = 0; m < 4; ++m) { int row = u.pm * BM + ai * HALF + wr * 64 + m * 16 + fr; EPI_PIN(row);
                    f32x4 gq;
#pragma unroll
                    for (int j = 0; j < 4; ++j) { const float za = z[0][m][j]; gq[j] = za * __builtin_amdgcn_rcpf(1.0f + __expf(-za)) * z[1][m][j]; }
                    u32x2 o; o.x = cvt_pk_bf16(gq[0], gq[1]); o.y = cvt_pk_bf16(gq[2], gq[3]);
                    *(u32x2*)(G + (size_t)row * DFF + c) = o; }
                if (lat) {
                    if (ai == 0 && wr == 0 && fr == 0) {
#pragma unroll
                        for (int ab = 0; ab < 2; ++ab) { *(f32x4*)(EDGE + ((size_t)(u.pm * 4 + 0) * 2 + ab) * DFF + c) = z[ab][0]; *(f32x4*)(EDGE + ((size_t)(u.pm * 4 + 2) * 2 + ab) * DFF + c) = acc[0][ab][0][n]; } }
                    if (ai == 1 && wr == 1 && fr == 15) {
#pragma unroll
                        for (int ab = 0; ab < 2; ++ab) { *(f32x4*)(EDGE + ((size_t)(u.pm * 4 + 1) * 2 + ab) * DFF + c) = z[ab][3]; *(f32x4*)(EDGE + ((size_t)(u.pm * 4 + 3) * 2 + ab) * DFF + c) = acc[1][ab][3][n]; } }
                }
                EPI_FENCE();
            }
        }
    }
};

struct EpiGateRes {
    static constexpr bool PERM = false;
    const float* base_ctx; const float* base_lat; float* out; const float* gate;
    __device__ __forceinline__ void operator()(const f32x4 (&acc)[2][2][4][2], const Unit& u, int wr, int wc, int fr, int fq, EPI_LAS float*) const {
        const int cond = (u.pm < NCTX / BM) ? 0 : 1 + (u.pm - NCTX / BM) / (LAT_T / BM);
        const int col0 = u.pn * BM + wc * 32 + 4 * fq; const float* gp = gate + (size_t)cond * (NMOD * DM) + col0;
        f32x4 gv[2][2];
#pragma unroll
        for (int bj = 0; bj < 2; ++bj)
#pragma unroll
            for (int n = 0; n < 2; ++n) gv[bj][n] = *(const f32x4*)(gp + bj * HALF + n * 16);
        const float* base = (u.pm < NCTX / BM) ? base_ctx : base_lat - (size_t)NCTX * DM;
#pragma unroll
        for (int ai = 0; ai < 2; ++ai)
#pragma unroll
            for (int m = 0; m < 4; ++m) { const size_t off = (size_t)(u.pm * BM + ai * HALF + wr * 64 + m * 16 + fr) * DM + col0;
#pragma unroll
                for (int bj = 0; bj < 2; ++bj)
#pragma unroll
                    for (int n = 0; n < 2; ++n) { const f32x4 bs = *(const f32x4*)(base + off + bj * HALF + n * 16); *(f32x4*)(out + off + bj * HALF + n * 16) = bs + gv[bj][n] * acc[ai][bj][m][n]; }
                if (m & 1) asm volatile("" ::: "memory"); }
    }
};
}
namespace att {
using bf16 = unsigned short;
constexpr int DQ = 192, DVV = 128, NW = 8, QBLK = 32, KVBLK = 64;
constexpr float SCALE = 0.07216878364870322f;
constexpr float THR = 8.f;
constexpr int LDQ = 8 * DQ, LDKK = 8 * DQ, LDVV = 8 * DVV, LDO = 2048;
constexpr int SHM_V = KVBLK * DVV * 2, SHM_K = KVBLK * DQ * 2, NQR = 6  , SHM_QR = NW * (12 - NQR) * 1024, SHM_ATTN = 2 * SHM_V + 2 * SHM_K + NW * 64 * 4 + SHM_QR;
using bf16x8 = __attribute__((ext_vector_type(8))) short;
using s16x4  = __attribute__((ext_vector_type(4))) short;
using f32x16 = __attribute__((ext_vector_type(16))) float;
using u32x4  = __attribute__((ext_vector_type(4))) unsigned;
#define KSWZ(row, colB) ((row) * 384 + ((colB) ^ ((((row) >> 1) & 7) << 4)))
#define SBAR() __builtin_amdgcn_sched_barrier(0)
__device__ __forceinline__ int crow(int r, int hi) { return (r & 3) + 8 * (r >> 2) + 4 * hi; }
__device__ __forceinline__ unsigned cvtpk(float lo, float hi) { unsigned r; asm volatile("v_cvt_pk_bf16_f32 %0, %1, %2" : "=v"(r) : "v"(lo), "v"(hi)); return r; }

__device__ __forceinline__ void partialSM(f32x16& p0, f32x16& p1, float& m_reg, float& mn, float& alpha) {
  constexpr float C = SCALE * 1.4426950408889634f;
  float pmax = p0[0];
#pragma unroll
  for (int r = 1; r < 16; ++r) pmax = fmaxf(pmax, p0[r]);
#pragma unroll
  for (int r = 0; r < 16; ++r) pmax = fmaxf(pmax, p1[r]);
  { auto rr = __builtin_amdgcn_permlane32_swap(__float_as_uint(pmax), __float_as_uint(pmax), false, false);
    pmax = fmaxf(__uint_as_float(rr[0]), __uint_as_float(rr[1])); }
  if (__builtin_expect(__all(pmax - m_reg <= THR / SCALE), 1)) { mn = m_reg; alpha = 1.f; }
  else { mn = fmaxf(m_reg, pmax); alpha = __builtin_amdgcn_exp2f((m_reg - mn) * C); m_reg = mn; }
  float mnC = -mn * C;
#pragma unroll
  for (int r = 0; r < 16; ++r) p0[r] = fmaf(p0[r], C, mnC);
#pragma unroll
  for (int r = 0; r < 16; ++r) p1[r] = fmaf(p1[r], C, mnC);
#pragma unroll
  for (int r = 0; r < 16; ++r) p0[r] = __builtin_amdgcn_exp2f(p0[r]);
}
__device__ __forceinline__ void finishSM(f32x16& p0, f32x16& p1, float alpha, float& l_reg, bf16x8& pa0, bf16x8& pa1, bf16x8& pa2, bf16x8& pa3) {
#pragma unroll
  for (int r = 0; r < 16; ++r) p1[r] = __builtin_amdgcn_exp2f(p1[r]);
  float ps = 0;
#pragma unroll
  for (int r = 0; r < 16; ++r) ps += p0[r];
#pragma unroll
  for (int r = 0; r < 16; ++r) ps += p1[r];
  { auto rr = __builtin_amdgcn_permlane32_swap(__float_as_uint(ps), __float_as_uint(ps), false, false);
    ps = __uint_as_float(rr[0]) + __uint_as_float(rr[1]); }
  l_reg = l_reg * alpha + ps;
#define PK4(P, BASE, OUT) do { unsigned a0 = cvtpk(P[BASE + 0], P[BASE + 1]), a1 = cvtpk(P[BASE + 2], P[BASE + 3]);   \
    unsigned b0 = cvtpk(P[BASE + 4], P[BASE + 5]), b1 = cvtpk(P[BASE + 6], P[BASE + 7]);                              \
    auto r0 = __builtin_amdgcn_permlane32_swap(a0, b0, false, false); auto r1 = __builtin_amdgcn_permlane32_swap(a1, b1, false, false); \
    u32x4 w = {r0[0], r1[0], r0[1], r1[1]}; OUT = *reinterpret_cast<bf16x8*>(&w); } while (0)
  PK4(p0, 0, pa0); PK4(p0, 8, pa1); PK4(p1, 0, pa2); PK4(p1, 8, pa3);
#undef PK4
}
__device__ __forceinline__ void qkt(f32x16& p0, f32x16& p1, const char* Ks, const bf16x8* qr, const char* qw, int r32, int hi) {
  p0 = f32x16{}; p1 = f32x16{};
#pragma unroll
  for (int d0 = 0; d0 < 12; ++d0) { int cb = (d0 * 16 + hi * 8) * 2;
    bf16x8 b0 = *reinterpret_cast<const bf16x8*>(Ks + KSWZ(r32, cb));
    bf16x8 b1 = *reinterpret_cast<const bf16x8*>(Ks + KSWZ(32 + r32, cb));
    const bf16x8 qf = (d0 < NQR) ? qr[d0 < NQR ? d0 : 0] : *reinterpret_cast<const bf16x8*>(qw + (d0 - NQR) * 1024);
    p0 = __builtin_amdgcn_mfma_f32_32x32x16_bf16(b0, qf, p0, 0, 0, 0);
    p1 = __builtin_amdgcn_mfma_f32_32x32x16_bf16(b1, qf, p1, 0, 0, 0); }
}
__device__ __forceinline__ int v_st(int k, int c) { const int kk = (k & ~0xC) | ((k & 4) << 1) | ((k & 8) >> 1); return ((kk >> 3) * 4 + (c >> 5)) * 512 + ((kk & 7) * 32 + (c & 31)) * 2; }
__device__ __forceinline__ int v_rd_base(int lane) { return ((lane & 3) << 3) | (((lane >> 2) & 3) << 6) | (((lane >> 4) & 1) << 5) | (((lane >> 5) & 1) << 8); }
constexpr int v_rd_off(int d0, int ks, int half) { return d0 * 512 + ks * 4096 + half * 2048; }
template <int OFF> __device__ __forceinline__ s16x4 tr_read(int vb) {
  s16x4 r; asm volatile("ds_read_b64_tr_b16 %0, %1 offset:%2" : "=&v"(r) : "v"(vb), "i"(OFF) : "memory"); return r;
}
template <int D0> __device__ __forceinline__ void pv_one(f32x16& od, int vb, bf16x8 pa0, bf16x8 pa1, bf16x8 pa2, bf16x8 pa3) {
  const s16x4 l0 = tr_read<v_rd_off(D0, 0, 0)>(vb), h0 = tr_read<v_rd_off(D0, 0, 1)>(vb), l1 = tr_read<v_rd_off(D0, 1, 0)>(vb), h1 = tr_read<v_rd_off(D0, 1, 1)>(vb);
  const s16x4 l2 = tr_read<v_rd_off(D0, 2, 0)>(vb), h2 = tr_read<v_rd_off(D0, 2, 1)>(vb), l3 = tr_read<v_rd_off(D0, 3, 0)>(vb), h3 = tr_read<v_rd_off(D0, 3, 1)>(vb);
  asm volatile("s_waitcnt lgkmcnt(0)" ::: "memory"); SBAR();
#define PK(L, H) (bf16x8){L[0], L[1], L[2], L[3], H[0], H[1], H[2], H[3]}
  od = __builtin_amdgcn_mfma_f32_32x32x16_bf16(pa0, PK(l0, h0), od, 0, 0, 0);
  od = __builtin_amdgcn_mfma_f32_32x32x16_bf16(pa1, PK(l1, h1), od, 0, 0, 0);
  od = __builtin_amdgcn_mfma_f32_32x32x16_bf16(pa2, PK(l2, h2), od, 0, 0, 0);
  od = __builtin_amdgcn_mfma_f32_32x32x16_bf16(pa3, PK(l3, h3), od, 0, 0, 0);
#undef PK
}
__device__ __forceinline__ void pv_d0(f32x16* o, int vb, bf16x8 pa0, bf16x8 pa1, bf16x8 pa2, bf16x8 pa3) {
  pv_one<0>(o[0], vb, pa0, pa1, pa2, pa3); pv_one<1>(o[1], vb, pa0, pa1, pa2, pa3); pv_one<2>(o[2], vb, pa0, pa1, pa2, pa3); pv_one<3>(o[3], vb, pa0, pa1, pa2, pa3);
}

__device__ __forceinline__ void attn_dense_body(const bf16* __restrict__ Qb, const bf16* __restrict__ Kh, const bf16* __restrict__ Vh, bf16* __restrict__ Ob, int seq, char* lds) {
  int tid_ = threadIdx.x; asm volatile("" : "+v"(tid_));
  const int tid = tid_, wid = tid >> 6, lane = tid & 63, r32 = lane & 31, hi = lane >> 5;
  char* V_lds = lds; char* K_lds = lds + 2 * SHM_V;
  float* ws = (float*)(lds + 2 * SHM_V + 2 * SHM_K) + wid * 64; float* li_l = ws; float* al_l = ws + 32;
  float m_reg = -1e30f, l_reg = 0; f32x16 o[4] = {}; bf16x8 qr[NQR];
  char* qw = lds + 2 * SHM_V + 2 * SHM_K + NW * 64 * 4 + wid * ((12 - NQR) * 1024) + lane * 16;
  const bf16* Qw = Qb + (long)(wid * QBLK + r32) * LDQ + hi * 8;
#pragma unroll
  for (int d0 = 0; d0 < NQR; ++d0) qr[d0] = *reinterpret_cast<const bf16x8*>(Qw + d0 * 16);
#pragma unroll
  for (int d0 = NQR; d0 < 12; ++d0) *reinterpret_cast<bf16x8*>(qw + (d0 - NQR) * 1024) = *reinterpret_cast<const bf16x8*>(Qw + d0 * 16);
  const int sr = tid >> 4, sc = (tid & 15) * 8, vst0 = v_st(sr, sc), vst1 = v_st(32 + sr, sc);
  int kg[3], kl[3];
#pragma unroll
  for (int i = 0; i < 3; ++i) { const int q = tid + 512 * i, kr_ = q / 24, kc = q % 24; kg[i] = kr_ * LDKK + kc * 8; kl[i] = KSWZ(kr_, kc * 16); }
  const int vb0 = (int)(uintptr_t)V_lds + v_rd_base(lane);
  bf16x8 vs0, vs1, ks0, ks1, ks2;
#define SLOAD(k0) do { vs0 = *(const bf16x8*)(&Vh[(long)((k0) + sr) * LDVV + sc]); vs1 = *(const bf16x8*)(&Vh[(long)((k0) + 32 + sr) * LDVV + sc]); \
    ks0 = *(const bf16x8*)(&Kh[(long)(k0) * LDKK + kg[0]]); ks1 = *(const bf16x8*)(&Kh[(long)(k0) * LDKK + kg[1]]); ks2 = *(const bf16x8*)(&Kh[(long)(k0) * LDKK + kg[2]]); } while (0)
#define SWRITE(b) do { *(bf16x8*)(V_lds + (b) * SHM_V + vst0) = vs0; *(bf16x8*)(V_lds + (b) * SHM_V + vst1) = vs1; \
    *(bf16x8*)(K_lds + (b) * SHM_K + kl[0]) = ks0; *(bf16x8*)(K_lds + (b) * SHM_K + kl[1]) = ks1; *(bf16x8*)(K_lds + (b) * SHM_K + kl[2]) = ks2; } while (0)
#define RESC(a) do { if (__any((a) < 1.f)) { if (hi == 0) al_l[r32] = (a); asm volatile("s_waitcnt lgkmcnt(0)" ::: "memory"); \
    _Pragma("unroll") for (int d = 0; d < 4; ++d) _Pragma("unroll") for (int r = 0; r < 16; ++r) o[d][r] *= al_l[crow(r, hi)]; } } while (0)
  f32x16 pA0, pA1, pB0, pB1; float mnA, mnB, alA, alB; bf16x8 pa0, pa1, pa2, pa3; const int NT = seq / KVBLK;
  SLOAD(0); asm volatile("s_waitcnt vmcnt(0)" ::: "memory"); SWRITE(0); __syncthreads();
  qkt(pA0, pA1, K_lds, qr, qw, r32, hi); partialSM(pA0, pA1, m_reg, mnA, alA);
  SLOAD(KVBLK);
  asm volatile("s_waitcnt vmcnt(0)" ::: "memory"); SWRITE(1); __syncthreads();
  for (int j = 1; j + 1 < NT; j += 2) {
    SBAR(); qkt(pB0, pB1, K_lds + SHM_K, qr, qw, r32, hi);
    finishSM(pA0, pA1, alA, l_reg, pa0, pa1, pa2, pa3); SBAR();
    SLOAD((j + 1) * KVBLK); SBAR();
    pv_d0(o, vb0, pa0, pa1, pa2, pa3); partialSM(pB0, pB1, m_reg, mnB, alB);
    __syncthreads(); asm volatile("s_waitcnt vmcnt(0)" ::: "memory"); SWRITE(0);
    RESC(alB); __syncthreads();
    SBAR(); qkt(pA0, pA1, K_lds, qr, qw, r32, hi);
    finishSM(pB0, pB1, alB, l_reg, pa0, pa1, pa2, pa3); SBAR();
    SLOAD((j + 2) * KVBLK); SBAR();
    pv_d0(o, vb0 + SHM_V, pa0, pa1, pa2, pa3); partialSM(pA0, pA1, m_reg, mnA, alA);
    __syncthreads(); asm volatile("s_waitcnt vmcnt(0)" ::: "memory"); SWRITE(1);
    RESC(alA); __syncthreads();
  }
  SBAR(); qkt(pB0, pB1, K_lds + SHM_K, qr, qw, r32, hi);
  finishSM(pA0, pA1, alA, l_reg, pa0, pa1, pa2, pa3); SBAR();
  pv_d0(o, vb0, pa0, pa1, pa2, pa3); partialSM(pB0, pB1, m_reg, mnB, alB);
  __syncthreads(); RESC(alB);
  finishSM(pB0, pB1, alB, l_reg, pa0, pa1, pa2, pa3); SBAR();
  pv_d0(o, vb0 + SHM_V, pa0, pa1, pa2, pa3);
  if (hi == 0) li_l[r32] = l_reg; asm volatile("s_waitcnt lgkmcnt(0)" ::: "memory");
  float rli[16];
#pragma unroll
  for (int r = 0; r < 16; ++r) rli[r] = __builtin_amdgcn_rcpf(li_l[crow(r, hi)]);
  bf16* Ow = Ob + (long)(wid * QBLK) * LDO;
#pragma unroll
  for (int r = 0; r < 16; ++r) { const int orow = crow(r, hi);
#pragma unroll
    for (int d0 = 0; d0 < 4; ++d0) { const float v = o[d0][r] * rli[r]; Ow[(long)orow * LDO + d0 * 32 + r32] = (bf16)(cvtpk(v, v) & 0xffffu); } }
  __syncthreads();
#undef SLOAD
#undef SWRITE
#undef RESC
}
#undef KSWZ
#undef SBAR
}
#ifndef MK_N_LAUNCHES
#define MK_N_LAUNCHES 1
#endif
constexpr int NWAVES = 8;
constexpr int N_PHASES = 10;
#ifndef MK_DUP
#define MK_DUP 0
#endif
constexpr int N_LAUNCHES = MK_N_LAUNCHES;

constexpr size_t MiB = 1u << 20;
constexpr size_t WS_CTL = 0, CTL_ZERO_BYTES = 1 * MiB;
constexpr size_t WS_MODP = 1 * MiB;
constexpr size_t WS_MOD = WS_MODP + 640 * 1024;
constexpr size_t WS_TAB = WS_MOD + 160 * 1024;
constexpr size_t WS_SSQQ = 2 * MiB;
constexpr size_t WS_SSQK = WS_SSQQ + 64 * 1024;
constexpr size_t WS_KPW = 3 * MiB;
constexpr size_t WS_WIN = 8 * MiB;
constexpr size_t WS_WPOOL = 16 * MiB;
constexpr size_t WS_WUQ = 17 * MiB;
constexpr size_t WS_WUKV = 19 * MiB;
constexpr size_t WS_WOUT = 20 * MiB;
constexpr size_t WS_WUP = 28 * MiB;
constexpr size_t WS_WDOWN = 72 * MiB;
constexpr size_t WS_G = 190 * MiB;
constexpr size_t WS_H = 94 * MiB;
constexpr size_t WS_U = 126 * MiB;
constexpr size_t WS_PV = 142 * MiB;
constexpr size_t WS_CQ = 158 * MiB;
constexpr size_t WS_CKVN = 166 * MiB;
constexpr size_t WS_UP = 182 * MiB;
constexpr size_t WS_Q = 182 * MiB;
constexpr size_t WS_K = 206 * MiB;
constexpr size_t WS_V = 233 * MiB;
constexpr size_t WS_MIX = 251 * MiB;
constexpr size_t WS_EDGE = 182 * MiB;
constexpr size_t WS_END = 358 * MiB;
static_assert(WS_G + (size_t)NTOK * DFF * 2 <= WS_END && WS_EDGE + (size_t)32 * 4 * 2 * DFF * 4 <= WS_G && WS_CKVN + (size_t)KVROWS * KVLORA * 2 <= WS_UP && WS_MIX + (size_t)NTOK * DM * 2 <= WS_END && WS_UP + (size_t)NTOK * 2 * DFF * 2 <= WS_END, "d_ws map");
constexpr int CW_BAR = 4096;

constexpr int RING_BYTES = 131072, SX_OFF = 139264  , MISC_OFF = SX_OFF + 8192, LDS_BYTES = 151552;
static_assert(att::SHM_ATTN <= SX_OFF && MISC_OFF + 256 <= LDS_BYTES, "LDS map");

#define GAS __attribute__((address_space(1)))
#define LAS __attribute__((address_space(3)))
typedef unsigned short bf16;
typedef unsigned v4u __attribute__((ext_vector_type(4)));
typedef unsigned v2u __attribute__((ext_vector_type(2)));
typedef float f32x4 __attribute__((ext_vector_type(4)));
typedef short bf16x8 __attribute__((ext_vector_type(8)));
#define LDS_WAIT() asm volatile("s_waitcnt lgkmcnt(0)" ::: "memory")
__device__ __forceinline__ unsigned f2bf(float f) { unsigned u = __builtin_bit_cast(unsigned, f); return (u + 0x7fffu + ((u >> 16) & 1u)) >> 16; }
__device__ __forceinline__ unsigned pk2(float lo, float hi) { return f2bf(lo) | (f2bf(hi) << 16); }
__device__ __forceinline__ float bflo(unsigned w) { return __builtin_bit_cast(float, w << 16); }
__device__ __forceinline__ float bfhi(unsigned w) { return __builtin_bit_cast(float, w & 0xffff0000u); }

#define XB_TMO      128
#define XB_XCNT(j)  (256  + 64 * (j))
#define XB_XSUB(j)  (1280 + 64 * (j))
#define XB_XGEN(j)  (2304 + 64 * (j))
#define XB_TOP      3328
#define XB_TOPGEN   3392
#define XCD_BAR_WORDS 3456
#define XB_SPIN_CAP (1u << 18)
__device__ __forceinline__ unsigned xb_ld(unsigned* p)              { return __hip_atomic_load(p, __ATOMIC_RELAXED, __HIP_MEMORY_SCOPE_AGENT); }
__device__ __forceinline__ unsigned xb_add(unsigned* p, unsigned v) { return __hip_atomic_fetch_add(p, v, __ATOMIC_RELAXED, __HIP_MEMORY_SCOPE_AGENT); }
__device__ __forceinline__ unsigned xb_xcc_id() { return (unsigned)__builtin_amdgcn_s_getreg((3 << 11) | 20) & 0xFu; }
#define XB_SPIN(cond, bar) do { unsigned _sp = 0; while (cond) { __builtin_amdgcn_s_sleep(1); \
    if ((++_sp & 255u) == 0u) { if (xb_ld(&(bar)[XB_TMO])) break; if (_sp > XB_SPIN_CAP) { atomicAdd(&(bar)[XB_TMO], 1u); break; } } } } while (0)
struct XcdBarrier { unsigned* bar; unsigned x; volatile LAS unsigned* st; };
__device__ __forceinline__ XcdBarrier xcd_barrier_post(unsigned* bar, volatile LAS unsigned* st) {
    XcdBarrier b; b.bar = bar; b.x = xb_xcc_id(); b.st = st;
    if (threadIdx.x == 0) (void)xb_add(&bar[XB_XCNT(b.x)], 1u);
    return b;
}
__device__ __forceinline__ void xcd_barrier_complete(unsigned* bar, unsigned x, unsigned& nloc, unsigned& nx) {
    const unsigned G = gridDim.x * gridDim.y * gridDim.z;
    unsigned sum, cnt, mine, sp = 0u;
    for (;;) {
        sum = 0u; cnt = 0u; mine = 0u;
#pragma unroll
        for (unsigned j = 0; j < 16; ++j) { const unsigned c = xb_ld(&bar[XB_XCNT(j)]); sum += c; cnt += (c > 0u) ? 1u : 0u; mine = (j == x) ? c : mine; }
        if (sum == G) break;
        __builtin_amdgcn_s_sleep(1);
        if ((++sp & 255u) == 0u) { if (xb_ld(&bar[XB_TMO])) break; if (sp > XB_SPIN_CAP) { atomicAdd(&bar[XB_TMO], 1u); break; } }
    }
    nloc = mine > 0u ? mine : 1u; nx = cnt > 0u ? cnt : 1u;
}
__device__ __forceinline__ void xcd_barrier(const XcdBarrier& b) {
    asm volatile("s_waitcnt vmcnt(0)" ::: "memory");
    __syncthreads();
    if (threadIdx.x == 0) {
        unsigned* bar = b.bar;
        __builtin_amdgcn_s_waitcnt(0);
        unsigned nloc = b.st[0], nx = b.st[1];
        if (nloc == 0u) { xcd_barrier_complete(bar, b.x, nloc, nx); b.st[0] = nloc; b.st[1] = nx; }
        const unsigned old = xb_add(&bar[XB_XSUB(b.x)], 1u);
        const unsigned gen = old / nloc;
        if (old + 1u == (gen + 1u) * nloc) {
            __builtin_amdgcn_fence(__ATOMIC_RELEASE, "agent");
            asm volatile("s_waitcnt vmcnt(0)" ::: "memory");
            const unsigned og = xb_add(&bar[XB_TOP], 1u);
            const unsigned tg = og / nx;
            if (og + 1u == (tg + 1u) * nx) xb_add(&bar[XB_TOPGEN], 1u);
            else XB_SPIN(xb_ld(&bar[XB_TOPGEN]) == tg, bar);
            __builtin_amdgcn_fence(__ATOMIC_ACQUIRE, "agent");
            xb_add(&bar[XB_XGEN(b.x)], 1u);
            asm volatile("s_waitcnt vmcnt(0)" ::: "memory");
        } else {
            XB_SPIN(xb_ld(&bar[XB_XGEN(b.x)]) == gen, bar);
            __builtin_amdgcn_fence(__ATOMIC_ACQUIRE, "agent");
            asm volatile("s_waitcnt vmcnt(0)" ::: "memory");
        }
    }
    __syncthreads();
}

struct Args {
    const float *x_prompt, *x_sample, *cache_ckv, *cache_kpe, *c, *c_ctx, *norm1_g, *norm2_g, *w_mod, *b_mod, *w_in, *w_pool, *pool_scale, *q_a_g, *w_uq, *kv_a_g, *w_ukv,
                *q_norm_g, *k_norm_g, *w_out, *w_up, *conv_w, *conv_b, *w_down;
    float* out; unsigned char* ws; int ph_lo, ph_hi, li, pad;
};
struct Frame {
    LAS unsigned char* lds; int tid, lane, wave, G, bid;
};
__device__ __forceinline__ float wave_sum(float v) {
#pragma unroll
    for (int o = 1; o < 64; o <<= 1) v += __shfl_xor(v, o);
    return v;
}
__device__ __forceinline__ float silu_f(float v) { return v / (1.0f + __expf(-v)); }

__device__ __forceinline__ void p0_transpose_item(const float* W, int N, int K, bf16* WT, int k0, int n0, int drow, const float* kscale, LAS float* scr, int lane) {
#pragma unroll 8
    for (int i = 0; i < 32; ++i) { const int kk = 2 * i + (lane >> 5); float v = W[(size_t)(k0 + kk) * N + n0 + (lane & 31)]; if (kscale) v *= kscale[k0 + kk]; scr[kk * 33 + (lane & 31)] = v; }
    LDS_WAIT(); asm volatile("" ::: "memory");
    const int c = lane & 7;
#pragma unroll
    for (int j = 0; j < 4; ++j) { const int n = (lane >> 3) + 8 * j; const LAS float* s = scr + (8 * c) * 33 + n;
        v4u o; o.x = pk2(s[0 * 33], s[1 * 33]); o.y = pk2(s[2 * 33], s[3 * 33]); o.z = pk2(s[4 * 33], s[5 * 33]); o.w = pk2(s[6 * 33], s[7 * 33]);
        *(GAS v4u*)(WT + (size_t)(drow + n) * K + k0 + 8 * c) = o; }
    LDS_WAIT(); asm volatile("" ::: "memory");
}
__device__ __forceinline__ void sincos_small(float x, float& s, float& c) {
    const double xd = (double)x; const double n = __builtin_rint(xd * 0.63661977236758134); const float r = (float)(xd - n * 1.5707963267948966); const int q = ((int)n) & 3;
    const float r2 = r * r;
    const float sp = r + r * r2 * (-1.6666667163e-01f + r2 * (8.3333337680e-03f + r2 * (-1.9841270114e-04f + r2 * 2.7557314297e-06f)));
    const float cp = 1.0f + r2 * (-0.5f + r2 * (4.1666667908e-02f + r2 * (-1.3888889225e-03f + r2 * (2.4801587642e-05f + r2 * -2.7557314297e-07f))));
    const float ss = (q & 1) ? cp : sp, cc = (q & 1) ? sp : cp;
    s = (q & 2) ? -ss : ss; c = ((q + 1) & 2) ? -cc : cc;
}

__device__ __forceinline__ void phase0(const Frame& F, const Args& a) {
    unsigned char* ws = a.ws;
    LAS float* sl = (LAS float*)F.lds;
    LAS float* red = sl + 3 * DM;
    for (int i = F.tid; i < 3 * DM; i += NWAVES * 64) { const int r = i / DM, k = i % DM; const float v = (r == 0) ? a.c_ctx[k] : a.c[(r - 1) * DM + k]; sl[i] = silu_f(v); }
    __syncthreads();
    float* MODP = (float*)(ws + WS_MODP);
    for (int task = F.bid; task < 768; task += F.G) {
        const int cb = task % 192, kq = task / 192, kbase = kq * 512 + F.wave * 64, rg = F.lane >> 4, cl = (F.lane & 15) * 4;
        f32x4 a0 = {0.f, 0.f, 0.f, 0.f}, a1 = a0, a2 = a0;
        const float* wp = a.w_mod + (size_t)(kbase + rg) * (NMOD * DM) + cb * 64 + cl;
#pragma unroll 4
        for (int i = 0; i < 16; ++i) { const f32x4 w = *(const f32x4*)(wp + (size_t)(4 * i) * (NMOD * DM)); const int k = kbase + 4 * i + rg;
            a0 += w * sl[k]; a1 += w * sl[DM + k]; a2 += w * sl[2 * DM + k]; }
#pragma unroll
        for (int j = 0; j < 4; ++j) { a0[j] += __shfl_xor(a0[j], 16); a0[j] += __shfl_xor(a0[j], 32); a1[j] += __shfl_xor(a1[j], 16); a1[j] += __shfl_xor(a1[j], 32); a2[j] += __shfl_xor(a2[j], 16); a2[j] += __shfl_xor(a2[j], 32); }
        if (rg == 0) { LAS float* rp = red + F.wave * 192 + cl; *(LAS f32x4*)rp = a0; *(LAS f32x4*)(rp + 64) = a1; *(LAS f32x4*)(rp + 128) = a2; }
        __syncthreads();
        if (F.tid < 192) { float s = 0.f;
#pragma unroll
            for (int w = 0; w < 8; ++w) s += red[w * 192 + F.tid];
            const int r = F.tid / 64, cc = F.tid % 64; MODP[((size_t)kq * 3 + r) * (NMOD * DM) + cb * 64 + cc] = s; }
        __syncthreads();
    }
    LAS float* scr = (LAS float*)(F.lds + 32768 + F.wave * 12288);
    const int gw = F.bid * NWAVES + F.wave, NGW = F.G * NWAVES;
    constexpr int I_IN = 32 * 58, I_POOL = 4 * 32, I_UQ = 8 * 48, I_UKV = 4 * 64, I_OUT = 32 * 64, I_UP = 32 * 352, I_DOWN = 88 * 64;
    constexpr int NITEMS = I_IN + I_POOL + I_UQ + I_UKV + I_OUT + I_UP + I_DOWN;
    bf16* WIN = (bf16*)(ws + WS_WIN); bf16* WPOOL = (bf16*)(ws + WS_WPOOL); bf16* WUQ = (bf16*)(ws + WS_WUQ); bf16* WUKV = (bf16*)(ws + WS_WUKV);
    bf16* WOUT = (bf16*)(ws + WS_WOUT); bf16* WUP = (bf16*)(ws + WS_WUP); bf16* WDOWN = (bf16*)(ws + WS_WDOWN);
    for (int it = gw; it < NITEMS; it += NGW) {
        int r = it;
        if (r < I_UP) { const int nb = r % 352, kb = r / 352, n0 = nb * 32; const int nn = n0 < DFF ? n0 : n0 - DFF; const int drow = (nn >> 7) * 256 + (nn & 127) + (n0 < DFF ? 0 : 128);
            p0_transpose_item(a.w_up, 2 * DFF, DM, WUP, kb * 64, n0, drow, nullptr, scr, F.lane); continue; } r -= I_UP;
        if (r < I_DOWN) { const int nb = r % 64, kb = r / 64; p0_transpose_item(a.w_down, DM, DFF, WDOWN, kb * 64, nb * 32, nb * 32, nullptr, scr, F.lane); continue; } r -= I_DOWN;
        if (r < I_OUT) { const int nb = r % 64, kb = r / 64; p0_transpose_item(a.w_out, DM, DM, WOUT, kb * 64, nb * 32, nb * 32, nullptr, scr, F.lane); continue; } r -= I_OUT;
        if (r < I_IN) { const int nb = r % 58, kb = r / 58; p0_transpose_item(a.w_in, INW, DM, WIN, kb * 64, nb * 32, nb * 32, nullptr, scr, F.lane); continue; } r -= I_IN;
        if (r < I_UQ) { const int nb = r % 48, kb = r / 48, n0 = nb * 32; const int drow = (n0 / DQK) * 256 + (n0 % DQK); p0_transpose_item(a.w_uq, NH * DQK, QLORA, WUQ, kb * 64, n0, drow, a.q_a_g, scr, F.lane); continue; } r -= I_UQ;
        if (r < I_UKV) { const int nb = r % 64, kb = r / 64; p0_transpose_item(a.w_ukv, NH * 256, KVLORA, WUKV, kb * 64, nb * 32, nb * 32, nullptr, scr, F.lane); continue; } r -= I_UKV;
        { const int g = r / 32, rr = r % 32, nb = rr % 8, kb = rr / 8; p0_transpose_item(a.w_pool + (size_t)g * 65536, 256, 256, WPOOL + (size_t)g * 65536, kb * 64, nb * 32, nb * 32, nullptr, scr, F.lane); }
    }
    const int gt = F.bid * (NWAVES * 64) + F.tid, NGT = F.G * NWAVES * 64;
    const v4u z4 = {0u, 0u, 0u, 0u};
    for (int i = gt; i < 49152 + 32768; i += NGT) {
        if (i < 49152) *(GAS v4u*)(WIN + (size_t)INW * DM + (size_t)i * 8) = z4;
        else { const int j = i - 49152, h = j / 4096, q = j % 4096; *(GAS v4u*)(WUQ + ((size_t)h * 256 + 192) * QLORA + (size_t)q * 8) = z4; }
    }
    float* TAB = (float*)(ws + WS_TAB);
    for (int i = gt; i < 1024; i += NGT) { const int pos = i >> 4, fi = i & 15; const float inv = powf(10000.0f, -(float)fi / 16.0f); float s, c; sincos_small((float)pos * inv, s, c); TAB[2 * i] = c; TAB[2 * i + 1] = s; }
    bf16* CKVN = (bf16*)(ws + WS_CKVN); float* KPW = (float*)(ws + WS_KPW); float* SSQK = (float*)(ws + WS_SSQK);
    for (int i = gw; i < LAT_B * PAST; i += NGW) { const int b = i / PAST, kr = NCTX + b * KVSEG + (i % PAST);
        const f32x4 v = *(const f32x4*)(a.cache_ckv + (size_t)i * KVLORA + F.lane * 4);
        v2u o; o.x = pk2(v[0], v[1]); o.y = pk2(v[2], v[3]); *(GAS v2u*)(CKVN + (size_t)kr * KVLORA + F.lane * 4) = o;
        const float kp = a.cache_kpe[(size_t)i * ROPED + F.lane]; KPW[(size_t)kr * ROPED + F.lane] = kp * a.k_norm_g[DNOPE + F.lane];
        const float ss = wave_sum(kp * kp); if (F.lane == 0) SSQK[kr] = ss; }
}

__device__ __forceinline__ void phase_norm(const Frame& F, const Args& a, int which) {
    unsigned char* ws = a.ws; const float* MODP = (const float*)(ws + WS_MODP); float* MOD = (float*)(ws + WS_MOD);
    LAS float* TA = (LAS float*)F.lds; LAS float* TS = TA + 3 * DM;
    const float* g = which ? a.norm2_g : a.norm1_g; const int csh = which ? 3 : 0, csc = which ? 4 : 1;
    for (int i = F.tid; i < 3 * DM; i += NWAVES * 64) { const int r = i / DM, c = i % DM; float sh, sc;
        if (which == 0) { const int i0 = r * (NMOD * DM) + csh * DM + c, i1 = r * (NMOD * DM) + csc * DM + c; sh = a.b_mod[csh * DM + c]; sc = a.b_mod[csc * DM + c];
#pragma unroll
            for (int q = 0; q < 4; ++q) { sh += MODP[(size_t)q * 3 * (NMOD * DM) + i0]; sc += MODP[(size_t)q * 3 * (NMOD * DM) + i1]; } }
        else { sh = MOD[r * (NMOD * DM) + csh * DM + c]; sc = MOD[r * (NMOD * DM) + csc * DM + c]; }
        TA[i] = g[c] * (1.0f + sc); TS[i] = sh; }
    if (which == 0) { const int gt = F.bid * (NWAVES * 64) + F.tid, NGT = F.G * NWAVES * 64;
        for (int i = gt; i < 3 * NMOD * DM; i += NGT) { float s = a.b_mod[i % (NMOD * DM)];
#pragma unroll
            for (int q = 0; q < 4; ++q) s += MODP[(size_t)q * 3 * (NMOD * DM) + i];
            MOD[i] = s; } }
    __syncthreads();
    bf16* H = (bf16*)(ws + WS_H); const int gw = F.bid * NWAVES + F.wave, NGW = F.G * NWAVES;
    for (int m = gw; m < NTOK; m += NGW) {
        const float* xrow = which ? a.out + (size_t)m * DM : (m < NCTX ? a.x_prompt + (size_t)m * DM : a.x_sample + (size_t)(m - NCTX) * DM);
        const int cond = m < NCTX ? 0 : 1 + ((m - NCTX) >> 11);
        const GAS f32x4* xr = (const GAS f32x4*)xrow + F.lane;
        f32x4 v[8]; float s = 0.f;
#pragma unroll
        for (int j = 0; j < 8; ++j) { v[j] = xr[64 * j]; s += (v[j][0] * v[j][0] + v[j][1] * v[j][1]) + (v[j][2] * v[j][2] + v[j][3] * v[j][3]); }
        const float rstd = 1.0f / sqrtf(wave_sum(s) * (1.0f / DM) + EPSN);
        GAS v2u* o8 = (GAS v2u*)(H + (size_t)m * DM) + F.lane;
#pragma unroll
        for (int j = 0; j < 8; ++j) { const int c = 256 * j + 4 * F.lane; const f32x4 ta = *(const LAS f32x4*)(TA + cond * DM + c), ts = *(const LAS f32x4*)(TS + cond * DM + c);
            const f32x4 h = v[j] * rstd * ta + ts; v2u w; w.x = pk2(h[0], h[1]); w.y = pk2(h[2], h[3]); o8[64 * j] = w; }
    }
}

__device__ __forceinline__ void phase_poolmix(const Frame& F, const Args& a) {
    unsigned char* ws = a.ws; const bf16* PV = (const bf16*)(ws + WS_PV); bf16* MIX = (bf16*)(ws + WS_MIX);
    const int gw = F.bid * NWAVES + F.wave, NGW = F.G * NWAVES;
    for (int it = gw; it < (NTOK / 2) * 4; it += NGW) {
        const int g = it & 3, rp = it >> 2, row = 2 * rp + (F.lane >> 5), col = g * 256 + (F.lane & 31) * 8, w = 2 << g;
        const int T = row < NCTX ? CTX_T : LAT_T, t = row < NCTX ? (row & (CTX_T - 1)) : ((row - NCTX) & (LAT_T - 1));
        const int lo = max(t - (w >> 1), 0), hi = min(t - (w >> 1) + w - 1, T - 1);
        float acc[8] = {0.f, 0.f, 0.f, 0.f, 0.f, 0.f, 0.f, 0.f};
        for (int j = 0; j < w; ++j) { const int tt = t - (w >> 1) + j; if (tt >= 0 && tt < T) { const v4u q = *(const GAS v4u*)(PV + (size_t)(row - t + tt) * POOLW + col);
            acc[0] += bflo(q.x); acc[1] += bfhi(q.x); acc[2] += bflo(q.y); acc[3] += bfhi(q.y); acc[4] += bflo(q.z); acc[5] += bfhi(q.z); acc[6] += bflo(q.w); acc[7] += bfhi(q.w); } }
        const v4u q = *(const GAS v4u*)(PV + (size_t)row * POOLW + col); const float ic = 1.0f / (float)(hi - lo + 1);
        const f32x4 s0 = *(const f32x4*)(a.pool_scale + col), s1 = *(const f32x4*)(a.pool_scale + col + 4);
        v4u o; o.x = pk2((acc[0] * ic - bflo(q.x)) * s0[0], (acc[1] * ic - bfhi(q.x)) * s0[1]); o.y = pk2((acc[2] * ic - bflo(q.y)) * s0[2], (acc[3] * ic - bfhi(q.y)) * s0[3]);
        o.z = pk2((acc[4] * ic - bflo(q.z)) * s1[0], (acc[5] * ic - bfhi(q.z)) * s1[1]); o.w = pk2((acc[6] * ic - bflo(q.w)) * s1[2], (acc[7] * ic - bfhi(q.w)) * s1[3]);
        *(GAS v4u*)(MIX + (size_t)row * DM + col) = o;
    }
}

__device__ __forceinline__ void phase_convgate(const Frame& F, const Args& a) {
    unsigned char* ws = a.ws; const bf16* UP = (const bf16*)(ws + WS_UP); bf16* Gb = (bf16*)(ws + WS_G);
    const int gw = F.bid * NWAVES + F.wave, NGW = F.G * NWAVES;
    for (int it = gw; it < (NTOK / 32) * 11; it += NGW) {
        const int strip = it % 11, blk = it / 11, c0 = strip * 512 + F.lane * 8, r0 = blk * 32;
        const int ua = (c0 >> 7) * 256 + (c0 & 127);
        const int T = r0 < NCTX ? CTX_T : LAT_T, t0 = r0 < NCTX ? (r0 & (CTX_T - 1)) : ((r0 - NCTX) & (LAT_T - 1));
        float wa[3][8], wb[3][8], ba[8], bb[8];
#pragma unroll
        for (int j = 0; j < 3; ++j)
#pragma unroll
            for (int e = 0; e < 8; ++e) { wa[j][e] = a.conv_w[(size_t)j * 2 * DFF + c0 + e]; wb[j][e] = a.conv_w[(size_t)j * 2 * DFF + DFF + c0 + e]; }
#pragma unroll
        for (int e = 0; e < 8; ++e) { ba[e] = a.conv_b[c0 + e]; bb[e] = a.conv_b[DFF + c0 + e]; }
        const v4u z4 = {0u, 0u, 0u, 0u};
        v4u pa = z4, pb = z4, ca, cb;
        if (t0 > 0) { pa = *(const GAS v4u*)(UP + (size_t)(r0 - 1) * (2 * DFF) + ua); pb = *(const GAS v4u*)(UP + (size_t)(r0 - 1) * (2 * DFF) + ua + 128); }
        ca = *(const GAS v4u*)(UP + (size_t)r0 * (2 * DFF) + ua); cb = *(const GAS v4u*)(UP + (size_t)r0 * (2 * DFF) + ua + 128);
        for (int i = 0; i < 32; ++i) {
            v4u na = z4, nb = z4;
            if (t0 + i + 1 < T) { na = *(const GAS v4u*)(UP + (size_t)(r0 + i + 1) * (2 * DFF) + ua); nb = *(const GAS v4u*)(UP + (size_t)(r0 + i + 1) * (2 * DFF) + ua + 128); }
            float g[8];
#define CG(e, PA, CA, NA, PB, CB, NB) { const float za = wa[0][e] * (PA) + wa[1][e] * (CA) + wa[2][e] * (NA) + ba[e]; const float zb = wb[0][e] * (PB) + wb[1][e] * (CB) + wb[2][e] * (NB) + bb[e]; g[e] = silu_f(za) * zb; }
            CG(0, bflo(pa.x), bflo(ca.x), bflo(na.x), bflo(pb.x), bflo(cb.x), bflo(nb.x)) CG(1, bfhi(pa.x), bfhi(ca.x), bfhi(na.x), bfhi(pb.x), bfhi(cb.x), bfhi(nb.x))
            CG(2, bflo(pa.y), bflo(ca.y), bflo(na.y), bflo(pb.y), bflo(cb.y), bflo(nb.y)) CG(3, bfhi(pa.y), bfhi(ca.y), bfhi(na.y), bfhi(pb.y), bfhi(cb.y), bfhi(nb.y))
            CG(4, bflo(pa.z), bflo(ca.z), bflo(na.z), bflo(pb.z), bflo(cb.z), bflo(nb.z)) CG(5, bfhi(pa.z), bfhi(ca.z), bfhi(na.z), bfhi(pb.z), bfhi(cb.z), bfhi(nb.z))
            CG(6, bflo(pa.w), bflo(ca.w), bflo(na.w), bflo(pb.w), bflo(cb.w), bflo(nb.w)) CG(7, bfhi(pa.w), bfhi(ca.w), bfhi(na.w), bfhi(pb.w), bfhi(cb.w), bfhi(nb.w))
#undef CG
            v4u o; o.x = pk2(g[0], g[1]); o.y = pk2(g[2], g[3]); o.z = pk2(g[4], g[5]); o.w = pk2(g[6], g[7]);
            *(GAS v4u*)(Gb + (size_t)(r0 + i) * DFF + c0) = o;
            pa = ca; pb = cb; ca = na; cb = nb;
        }
    }
}

__device__ __forceinline__ void phase_convfix(const Frame& F, const Args& a) {
    unsigned char* ws = a.ws; const float* EDGE = (const float*)(ws + WS_EDGE); bf16* Gb = (bf16*)(ws + WS_G);
    const int gw = F.bid * NWAVES + F.wave, NGW = F.G * NWAVES;
    for (int it = gw; it < 14 * 22; it += NGW) {
        const int bd = it / 22, c = (it % 22) * 256 + F.lane * 4, pm = 16 + (bd / 7) * 8 + (bd % 7);
        f32x4 z1[2], z2[2];
#pragma unroll
        for (int ab = 0; ab < 2; ++ab) {
            const f32x4 zl = *(const f32x4*)(EDGE + ((size_t)(pm * 4 + 1) * 2 + ab) * DFF + c), uf = *(const f32x4*)(EDGE + ((size_t)((pm + 1) * 4 + 2) * 2 + ab) * DFF + c);
            const f32x4 zf = *(const f32x4*)(EDGE + ((size_t)((pm + 1) * 4 + 0) * 2 + ab) * DFF + c), ul = *(const f32x4*)(EDGE + ((size_t)(pm * 4 + 3) * 2 + ab) * DFF + c);
            const f32x4 w0 = *(const f32x4*)(a.conv_w + ab * DFF + c), w2 = *(const f32x4*)(a.conv_w + (size_t)2 * (2 * DFF) + ab * DFF + c);
            z1[ab] = zl + w2 * uf; z2[ab] = zf + w0 * ul; }
        v2u o1, o2; float g1[4], g2[4];
#pragma unroll
        for (int j = 0; j < 4; ++j) { g1[j] = silu_f(z1[0][j]) * z1[1][j]; g2[j] = silu_f(z2[0][j]) * z2[1][j]; }
        o1.x = pk2(g1[0], g1[1]); o1.y = pk2(g1[2], g1[3]); o2.x = pk2(g2[0], g2[1]); o2.y = pk2(g2[2], g2[3]);
        const size_t r1 = (size_t)pm * 256 + 255;
        *(GAS v2u*)(Gb + r1 * DFF + c) = o1; *(GAS v2u*)(Gb + (r1 + 1) * DFF + c) = o2;
    }
}

__global__ void __launch_bounds__(NWAVES * 64, 2) mk_fwd(Args args) {
    extern __shared__ __attribute__((aligned(16))) unsigned char lds[];
    Frame F;
    F.lds = (LAS unsigned char*)lds; F.tid = threadIdx.x; F.lane = F.tid & 63; F.wave = __builtin_amdgcn_readfirstlane(F.tid >> 6); F.G = gridDim.x; F.bid = blockIdx.x;
    volatile LAS unsigned* MISC = (volatile LAS unsigned*)(F.lds + MISC_OFF);
    unsigned char* ws = args.ws;
    for (int u = F.tid; u < 64; u += NWAVES * 64) MISC[u] = 0u;
    __syncthreads();
    XcdBarrier bar; bar.bar = (unsigned*)(ws + WS_CTL) + CW_BAR; bar.x = 0; bar.st = nullptr;
    if (N_LAUNCHES == 1) bar = xcd_barrier_post((unsigned*)(ws + WS_CTL) + CW_BAR, MISC + 8);
    const int lo = args.ph_lo, hi = args.ph_hi;
#define IN(k) (lo <= (k) && (k) < hi)
#define REP(k) for (int rep_ = 0; rep_ < 1 + ((MK_DUP >> (k)) & 1); ++rep_)
#define SEAM(k) do { if (IN(k) && IN((k) + 1)) xcd_barrier(bar); } while (0)
    LAS float* sx = (LAS float*)(F.lds + SX_OFF);
    bf16* WIN = (bf16*)(ws + WS_WIN); bf16* WPOOL = (bf16*)(ws + WS_WPOOL); bf16* WUQ = (bf16*)(ws + WS_WUQ); bf16* WUKV = (bf16*)(ws + WS_WUKV);
    bf16* WOUT = (bf16*)(ws + WS_WOUT); bf16* WUP = (bf16*)(ws + WS_WUP); bf16* WDOWN = (bf16*)(ws + WS_WDOWN);
    bf16* Hb = (bf16*)(ws + WS_H); bf16* Ub = (bf16*)(ws + WS_U); bf16* PVb = (bf16*)(ws + WS_PV); bf16* CQb = (bf16*)(ws + WS_CQ); bf16* CKVN = (bf16*)(ws + WS_CKVN);
    bf16* Qb = (bf16*)(ws + WS_Q); bf16* Kb = (bf16*)(ws + WS_K); bf16* Vb = (bf16*)(ws + WS_V); bf16* MIX = (bf16*)(ws + WS_MIX); bf16* UPb = (bf16*)(ws + WS_UP); bf16* Gb = (bf16*)(ws + WS_G);
    float* MOD = (float*)(ws + WS_MOD); float* TAB = (float*)(ws + WS_TAB); float* SSQQ = (float*)(ws + WS_SSQQ); float* SSQK = (float*)(ws + WS_SSQK); float* KPW = (float*)(ws + WS_KPW);

    if (IN(0)) REP(0) { phase0(F, args); } SEAM(0);
    if (IN(1)) REP(1) { phase_norm(F, args, 0); } SEAM(1);
    if (IN(2)) REP(2) {
        pg8::Gemm g{Hb, WIN}; pg8::StaticOrder S; S.init(NTOK, 2048, F.G, F.bid);
        epi::EpiIn E{Ub, CQb, CKVN, SSQQ, SSQK, KPW, args.out + (size_t)NTOK * DM, args.out + (size_t)NTOK * DM + (size_t)NCTX * KVLORA, args.kv_a_g, args.k_norm_g, TAB};
        pg8::gemm_phase<pg8::Geo<DM, DM, DM, 0>>(F.lds, sx, g, S, E);
    } SEAM(2);
    if (IN(3)) REP(3) {
        { pg8::Gemm g{Ub, WPOOL}; pg8::StaticOrder S; S.init(NTOK, 1024, F.G, (F.bid + 128) % F.G); epi::EpiBf16<POOLW> E{PVb}; pg8::gemm_phase<pg8::Geo<POOLW, 256, 256, 512>>(F.lds, sx, g, S, E); }
        { pg8::Gemm g{CQb, WUQ}; pg8::StaticOrder S; S.init(NTOK, 2048, F.G, F.bid); epi::EpiQ E{Qb, SSQQ, args.q_norm_g, TAB}; pg8::gemm_phase<pg8::Geo<QLORA, QLORA, QLORA, 0>>(F.lds, sx, g, S, E); }
        { pg8::Gemm g{CKVN, WUKV}; pg8::StaticOrder S; S.init(KVROWS, 2048, F.G, F.bid); epi::EpiKV E{Kb, Vb, SSQK, KPW, args.k_norm_g}; pg8::gemm_phase<pg8::Geo<KVLORA, KVLORA, KVLORA, 0>>(F.lds, sx, g, S, E); }
    } SEAM(3);
    if (IN(4)) REP(4) {
        phase_poolmix(F, args);
        for (int c = F.bid; c < 256; c += F.G) {
            const int h = c & 7;
            if (c < 128) { const int b = c >> 6, qb = (c >> 3) & 7; const size_t q0 = (size_t)NCTX + (size_t)b * LAT_T + (size_t)qb * 256, k0 = (size_t)NCTX + (size_t)b * KVSEG;
                att::attn_dense_body(Qb + q0 * (NH * DQK) + h * DQK, Kb + k0 * (NH * DQK) + h * DQK, Vb + k0 * (NH * DVH) + h * DVH, MIX + q0 * DM + POOLW + h * DVH, KVSEG, (char*)lds); }
            else { const int b = (c - 128) >> 3; const size_t q0 = (size_t)b * CTX_T;
                att::attn_dense_body(Qb + q0 * (NH * DQK) + h * DQK, Kb + q0 * (NH * DQK) + h * DQK, Vb + q0 * (NH * DVH) + h * DVH, MIX + q0 * DM + POOLW + h * DVH, CTX_T, (char*)lds); }
        }
    } SEAM(4);
    if (IN(5)) REP(5) {
        pg8::Gemm g{MIX, WOUT}; pg8::StaticOrder S; S.init(NTOK, DM, F.G, F.bid);
        epi::EpiGateRes E{args.x_prompt, args.x_sample, args.out, MOD + 2 * DM}; pg8::gemm_phase<pg8::Geo<DM, DM, DM, 0>>(F.lds, sx, g, S, E);
    } SEAM(5);
    if (IN(6)) REP(6) { phase_norm(F, args, 1); } SEAM(6);
    if (IN(7)) REP(7) {
        pg8::Gemm g{Hb, WUP}; pg8::StaticOrder S; S.init(NTOK, 2 * DFF, F.G, F.bid); epi::EpiUpConv E{Gb, (float*)(ws + WS_EDGE), args.conv_w, args.conv_b}; pg8::gemm_phase<pg8::Geo<DM, DM, DM, 0>>(F.lds, sx, g, S, E);
    } SEAM(7);
    if (IN(8)) REP(8) { phase_convfix(F, args); } SEAM(8);
#if defined(MK_PROBE9)
    if (IN(9)) { pg8::Gemm g{Gb, WDOWN}; pg8::StaticOrder S; S.init(NTOK, DM, F.G, F.bid);
        epi::EpiGateRes E{args.out, args.out + (size_t)NCTX * DM, (float*)(ws + WS_UP), MOD + 5 * DM}; pg8::gemm_phase<pg8::Geo<DFF, DFF, DFF, 0>>(F.lds, sx, g, S, E); }
#endif
#if defined(MK_PROBEBAR)
    if (IN(9)) { for (int i = 0; i < 10; ++i) xcd_barrier(bar); }
#endif
    if (IN(9)) REP(9) {
        pg8::Gemm g{Gb, WDOWN}; pg8::StaticOrder S; S.init(NTOK, DM, F.G, F.bid);
        epi::EpiGateRes E{args.out, args.out + (size_t)NCTX * DM, args.out, MOD + 5 * DM}; pg8::gemm_phase<pg8::Geo<DFF, DFF, DFF, 0>>(F.lds, sx, g, S, E);
    }
#undef IN
#undef SEAM
}

extern "C" void kernel_launch(void* const* d_in, const int* in_sizes, int n_in, void* d_out, int out_size, void* d_ws, size_t ws_size, hipStream_t stream) {
    static int grid = 0;
    if (grid == 0) {
        if (n_in != 24 || in_sizes[0] != NCTX * DM || in_sizes[8] != DM * NMOD * DM || ws_size < WS_END) {
            fprintf(stderr, "kernel_launch: unexpected shapes: n_in %d in0 %d in8 %d ws %zu (need >= %zu); nothing launched\n", n_in, n_in > 0 ? in_sizes[0] : -1, n_in > 8 ? in_sizes[8] : -1, ws_size, (size_t)WS_END); grid = -1; return; }
        int dev = 0, cus = 0;
        if (hipGetDevice(&dev) != hipSuccess || hipDeviceGetAttribute(&cus, hipDeviceAttributeMultiprocessorCount, dev) != hipSuccess) { fprintf(stderr, "kernel_launch: device query failed\n"); grid = -1; return; }
        if (hipFuncSetAttribute((const void*)mk_fwd, hipFuncAttributeMaxDynamicSharedMemorySize, LDS_BYTES) != hipSuccess) { fprintf(stderr, "kernel_launch: hipFuncSetAttribute failed\n"); grid = -1; return; }
        (void)hipGetLastError();
        grid = cus;
    }
    if (grid < 0) return;
    if (hipMemsetAsync((char*)d_ws + WS_CTL, 0, CTL_ZERO_BYTES, stream) != hipSuccess) { fprintf(stderr, "kernel_launch: memset failed\n"); return; }
    Args a{};
    const float** ap = (const float**)&a;
    for (int i = 0; i < 24; ++i) ap[i] = (const float*)d_in[i];
    a.out = (float*)d_out; a.ws = (unsigned char*)d_ws;
    for (int li = 0; li < N_LAUNCHES; ++li) {
        a.ph_lo = (N_LAUNCHES == 1) ? 0 : li; a.ph_hi = (N_LAUNCHES == 1) ? N_PHASES : li + 1; a.li = li;
        hipLaunchKernelGGL(mk_fwd, dim3(grid), dim3(NWAVES * 64), LDS_BYTES, stream, a);
        const hipError_t le = hipPeekAtLastError();
        if (le != hipSuccess) { fprintf(stderr, "kernel_launch: launch %d failed: %s\n", li, hipGetErrorName(le)); break; }
    }
}
```

```cpp
#include <hip/hip_runtime.h>
#include <cstdio>
#include <cstdint>
namespace pg8 {
#define PG8_LAS __attribute__((address_space(3)))
typedef unsigned short bf16_t;
typedef short bf16x8 __attribute__((ext_vector_type(8)));
typedef float f32x4 __attribute__((ext_vector_type(4)));
typedef float f32x2 __attribute__((ext_vector_type(2)));
typedef unsigned u32x4 __attribute__((ext_vector_type(4)));
typedef unsigned u32x2 __attribute__((ext_vector_type(2)));
constexpr int BM = 256, BK = 64, HALF = 128, HTB = HALF * BK * 2  , STAGE_BYTES = 8 * HTB, NXCD = 8, WGM = 8;

__host__ __device__ __forceinline__ int lds_byte(int r, int c) { const int st = (r >> 4) * 2 + (c >> 5), rr = r & 15, cc = c & 31, ob = rr * 64 + cc * 2; return st * 1024 + (ob ^ (((ob >> 9) & 1) << 5)); }
__host__ __device__ __forceinline__ void stage_rc(int b, int& R, int& C) { const int st = b / 1024, sb = b % 1024, swz = sb ^ (((sb >> 9) & 1) << 5); R = (st >> 1) * 16 + swz / 64; C = (st & 1) * 32 + (swz % 64) / 2; }
__host__ __device__ __forceinline__ int perm32(int rho) { const int n = rho >> 4, i = rho & 15; return 8 * (i >> 2) + 4 * n + (i & 3); }

struct Unit { int pm, pn; };
struct Gemm { const bf16_t* A; const bf16_t* Bt; };
template <int LDA, int LDB, int KK, int APN> struct Geo { static constexpr int lda = LDA, ldb = LDB, K = KK, a_pn_bytes = APN; };

struct StaticOrder {
    int nM, nN, nwg, G, c;
    __host__ __device__ void init(int M, int N, int G_, int c_) { nM = M / BM; nN = N / BM; nwg = nM * nN; G = G_; c = c_; }
    __host__ __device__ bool next(int i, Unit& u) const {
        const long L = (long)i * G + c; if (L >= nwg) return false;
        int wgid = (int)L; { const int q = nwg / NXCD, r = nwg % NXCD, xcd = wgid % NXCD, off = wgid / NXCD; wgid = (xcd < r ? xcd * (q + 1) : r * (q + 1) + (xcd - r) * q) + off; }
        const int nig = WGM * nN, gid = wgid / nig, fm = gid * WGM, gsz = (nM - fm) < WGM ? (nM - fm) : WGM;
        u.pm = fm + ((wgid % nig) % gsz); u.pn = (wgid % nig) / gsz; return true;
    }
};

__device__ __forceinline__ unsigned cvt_pk_bf16(float lo, float hi) { unsigned r; asm volatile("v_cvt_pk_bf16_f32 %0, %1, %2" : "=v"(r) : "v"(lo), "v"(hi)); return r; }


template <class GEO, class Epi, class Sched>
__device__ __forceinline__ void gemm_phase(PG8_LAS unsigned char* lds, PG8_LAS float* sx, const Gemm g, const Sched& S, const Epi& E) {
    int tid_ = threadIdx.x; asm volatile("" : "+v"(tid_));
    const int tid = tid_, wid = __builtin_amdgcn_readfirstlane(tid >> 6), lane = tid & 63, wr = wid >> 2, wc = wid & 3, fr = lane & 15, fq = lane >> 4;
    constexpr int K = GEO::K, nt = K / BK;
    unsigned voffA[2], voffB[2];
#pragma unroll
    for (int i = 0; i < 2; ++i) { int R, C; stage_rc(tid * 16 + i * 8192, R, C); const int Rb = Epi::PERM ? ((R & ~31) + perm32(R & 31)) : R;
        voffA[i] = (unsigned)(R * GEO::lda + C) * 2u; voffB[i] = (unsigned)(Rb * GEO::ldb + C) * 2u; }
    const size_t kstep = (size_t)(BK * 2);
    const size_t hstepA = (size_t)HALF * GEO::lda * 2, hstepB = (size_t)HALF * GEO::ldb * 2;
    const size_t tstepA = 2 * hstepA, tstepB = 2 * hstepB;
    const unsigned ldsw = (unsigned)wid * 1024u;
    const int aoff = lds_byte(wr * 64 + fr, fq * 8), boff = lds_byte(wc * 32 + fr, fq * 8);
#define PG8_SA(b, h) (((b) * 2 + (h)) * HTB)
#define PG8_SB(b, h) ((4 + (b) * 2 + (h)) * HTB)
#define PG8_STAGE(bufoff, gbase, voff) do { _Pragma("unroll") for (int _i = 0; _i < 2; ++_i) \
        __builtin_amdgcn_global_load_lds((const unsigned*)((const char*)(gbase) + (voff)[_i]), (PG8_LAS unsigned*)(lds + (bufoff) + ldsw + _i * 8192), 16, 0, 0); } while (0)
#define PG8_LDA(dst, b, h) do { _Pragma("unroll") for (int m = 0; m < 4; ++m) _Pragma("unroll") for (int k = 0; k < 2; ++k) dst[m][k] = *(const PG8_LAS bf16x8*)(lds + PG8_SA(b, h) + aoff + m * 2048 + k * 1024); } while (0)
#define PG8_LDB(dst, b, h) do { _Pragma("unroll") for (int n = 0; n < 2; ++n) _Pragma("unroll") for (int k = 0; k < 2; ++k) dst[n][k] = *(const PG8_LAS bf16x8*)(lds + PG8_SB(b, h) + boff + n * 2048 + k * 1024); } while (0)
#define PG8_MMA(ai, bj, At, Bt) do { __builtin_amdgcn_s_setprio(1); _Pragma("unroll") for (int m = 0; m < 4; ++m) _Pragma("unroll") for (int n = 0; n < 2; ++n) _Pragma("unroll") for (int k = 0; k < 2; ++k) \
        acc[ai][bj][m][n] = __builtin_amdgcn_mfma_f32_16x16x32_bf16(Bt[n][k], At[m][k], acc[ai][bj][m][n], 0, 0, 0); __builtin_amdgcn_s_setprio(0); } while (0)
#define PG8_WAIT_V(n) asm volatile("s_waitcnt vmcnt(" #n ")" ::: "memory")
#define PG8_WAIT_L(n) asm volatile("s_waitcnt lgkmcnt(" #n ")" ::: "memory")
#define PG8_BAR __builtin_amdgcn_s_barrier()
#define PG8_SCHED __builtin_amdgcn_sched_barrier(0)
    Unit cur, nxt; int ui = 0;
    if (!S.next(0, cur)) return;
    f32x4 acc[2][2][4][2];
#pragma unroll
    for (int a = 0; a < 2; ++a)
#pragma unroll
        for (int b = 0; b < 2; ++b)
#pragma unroll
            for (int m = 0; m < 4; ++m)
#pragma unroll
                for (int n = 0; n < 2; ++n) acc[a][b][m][n] = (f32x4){0.f, 0.f, 0.f, 0.f};
    bf16x8 At[4][2], B0[2][2], B1[2][2];
    const char* cA = (const char*)g.A + (size_t)cur.pm * tstepA + (size_t)cur.pn * GEO::a_pn_bytes; const char* cB = (const char*)g.Bt + (size_t)cur.pn * tstepB;
    PG8_STAGE(PG8_SB(0, 0), cB, voffB); PG8_STAGE(PG8_SB(0, 1), cB + hstepB, voffB); PG8_STAGE(PG8_SA(0, 0), cA, voffA); PG8_STAGE(PG8_SA(0, 1), cA + hstepA, voffA);
    if (wr == 1) PG8_BAR;
    PG8_WAIT_V(2); PG8_BAR;
    PG8_STAGE(PG8_SB(1, 0), cB + kstep, voffB); PG8_STAGE(PG8_SA(1, 0), cA + kstep, voffA); PG8_STAGE(PG8_SB(1, 1), cB + hstepB + kstep, voffB);
    PG8_WAIT_V(6); PG8_BAR;
    for (;;) {
        const bool has_next = S.next(ui + 1, nxt);
        const char* nA = has_next ? (const char*)g.A + (size_t)nxt.pm * tstepA + (size_t)nxt.pn * GEO::a_pn_bytes : cA; const char* nB = has_next ? (const char*)g.Bt + (size_t)nxt.pn * tstepB : cB;
#pragma unroll 1
        for (int t = 0; t < nt; t += 2) {
            const bool last = (t == nt - 2);
            const char* a1 = cA + (size_t)(t + 1) * kstep;
            const char* a2 = last ? nA : cA + (size_t)(t + 2) * kstep; const char* b2 = last ? nB : cB + (size_t)(t + 2) * kstep;
            const char* a3 = a2 + kstep; const char* b3 = b2 + kstep;
            PG8_LDB(B0, 0, 0); PG8_LDB(B1, 0, 1); PG8_SCHED; PG8_LDA(At, 0, 0); PG8_STAGE(PG8_SA(1, 1), a1 + hstepA, voffA);
            PG8_WAIT_V(8); PG8_WAIT_L(0); PG8_BAR; PG8_MMA(0, 0, At, B0); PG8_MMA(0, 1, At, B1); PG8_BAR; PG8_SCHED;
            PG8_LDA(At, 0, 1); PG8_STAGE(PG8_SB(0, 0), b2, voffB); PG8_STAGE(PG8_SB(0, 1), b2 + hstepB, voffB); PG8_STAGE(PG8_SA(0, 0), a2, voffA);
            PG8_WAIT_V(8); PG8_WAIT_L(0); PG8_BAR; PG8_MMA(1, 0, At, B0); PG8_MMA(1, 1, At, B1); PG8_BAR; PG8_SCHED;
            PG8_LDB(B0, 1, 0); PG8_LDB(B1, 1, 1); PG8_SCHED; PG8_LDA(At, 1, 0); PG8_STAGE(PG8_SA(0, 1), a2 + hstepA, voffA);
            PG8_WAIT_V(8); PG8_WAIT_L(0); PG8_BAR; PG8_MMA(0, 0, At, B0); PG8_MMA(0, 1, At, B1); PG8_BAR; PG8_SCHED;
            PG8_LDA(At, 1, 1); PG8_STAGE(PG8_SB(1, 0), b3, voffB); PG8_STAGE(PG8_SB(1, 1), b3 + hstepB, voffB); PG8_STAGE(PG8_SA(1, 0), a3, voffA);
            PG8_WAIT_V(8); PG8_WAIT_L(0); PG8_BAR; PG8_MMA(1, 0, At, B0); PG8_MMA(1, 1, At, B1); PG8_BAR; PG8_SCHED;
        }
        if (wr == 0) PG8_BAR;
        { int fr_ = fr, fq_ = fq; asm volatile("" : "+v"(fr_), "+v"(fq_));
          E(acc, cur, wr, wc, fr_, fq_, sx); }
        if (!has_next) break;
#pragma unroll
        for (int a = 0; a < 2; ++a)
#pragma unroll
            for (int b = 0; b < 2; ++b)
#pragma unroll
                for (int m = 0; m < 4; ++m)
#pragma unroll
                    for (int n = 0; n < 2; ++n) acc[a][b][m][n] = (f32x4){0.f, 0.f, 0.f, 0.f};
        cur = nxt; cA = nA; cB = nB; ++ui;
        if (wr == 1) PG8_BAR;
    }
    PG8_WAIT_V(0);
    PG8_BAR;
#undef PG8_SA
#undef PG8_SB
#undef PG8_STAGE
#undef PG8_LDA
#undef PG8_LDB
#undef PG8_MMA
}
}
constexpr int DM = 2048, NTOK = 8192, NCTX = 4096, LAT_T = 2048, LAT_B = 2, CTX_T = 256, PAST = 512;
constexpr int KVSEG = PAST + LAT_T;
constexpr int KVROWS = NCTX + LAT_B * KVSEG;
constexpr int POOLW = 1024, QLORA = 512, KVLORA = 256, ROPED = 64, INW = 1856, NH = 8, DQK = 192, DNOPE = 128, DVH = 128, DFF = 5632, NMOD = 6;
constexpr float EPSN = 1e-6f;

__device__ __forceinline__ int kvrow_of(int row) { return row < NCTX ? row : NCTX + ((row - NCTX) >> 11) * KVSEG + PAST + ((row - NCTX) & (LAT_T - 1)); }

namespace epi {
using namespace pg8;
#define EPI_LAS __attribute__((address_space(3)))
__device__ __forceinline__ float fq_sum(float s) { s += __shfl_xor(s, 16); s += __shfl_xor(s, 32); return s; }
__device__ __forceinline__ void lds_bar() { asm volatile("s_waitcnt lgkmcnt(0)" ::: "memory"); __builtin_amdgcn_s_barrier(); asm volatile("" ::: "memory"); }
__device__ __forceinline__ u32x4 pack8(const f32x4 a, const f32x4 b) { u32x4 w; w.x = cvt_pk_bf16(a[0], a[1]); w.y = cvt_pk_bf16(a[2], a[3]); w.z = cvt_pk_bf16(b[0], b[1]); w.w = cvt_pk_bf16(b[2], b[3]); return w; }
__device__ __forceinline__ float sq4(const f32x4 v) { return (v[0] * v[0] + v[1] * v[1]) + (v[2] * v[2] + v[3] * v[3]); }

template <int ldc> struct EpiBf16 {
    static constexpr bool PERM = true;
    bf16_t* O;
    __device__ __forceinline__ void operator()(const f32x4 (&acc)[2][2][4][2], const Unit& u, int wr, int wc, int fr, int fq, EPI_LAS float*) const {
        const int row0 = u.pm * BM + wr * 64 + fr, col0 = u.pn * BM + wc * 32 + 8 * fq;
#pragma unroll
        for (int ai = 0; ai < 2; ++ai)
#pragma unroll
            for (int m = 0; m < 4; ++m) { bf16_t* rowp = O + (size_t)(row0 + ai * HALF + m * 16) * ldc + col0;
#pragma unroll
                for (int bj = 0; bj < 2; ++bj) *(u32x4*)(rowp + bj * HALF) = pack8(acc[ai][bj][m][0], acc[ai][bj][m][1]); }
    }
};

__device__ __forceinline__ f32x4 rope4(const f32x4 w, const float* tab, int pos, int fq, int n) {
    f32x4 p; p[0] = __shfl_xor(w[0], 32); p[1] = __shfl_xor(w[1], 32); p[2] = __shfl_xor(w[2], 32); p[3] = __shfl_xor(w[3], 32);
    const float* tp = tab + ((size_t)pos * 16 + 8 * (fq & 1) + 4 * n) * 2;
    const f32x4 c0 = *(const f32x4*)tp, c1 = *(const f32x4*)(tp + 4);
    const float sg = (fq < 2) ? -1.f : 1.f;
    f32x4 o; o[0] = w[0] * c0[0] + sg * p[0] * c0[1]; o[1] = w[1] * c0[2] + sg * p[1] * c0[3]; o[2] = w[2] * c1[0] + sg * p[2] * c1[1]; o[3] = w[3] * c1[2] + sg * p[3] * c1[3];
    return o;
}

struct EpiIn {
    static constexpr bool PERM = true;
    bf16_t* U; bf16_t* CQ; bf16_t* CKVN; float* SSQQ; float* SSQK; float* KPW; float* out_ckv; float* out_kpe;
    const float* kv_a_g; const float* k_norm_g; const float* tab;
    __device__ __forceinline__ void operator()(const f32x4 (&acc)[2][2][4][2], const Unit& u, int wr, int wc, int fr, int fq, EPI_LAS float* part) const {
        const int pn = u.pn, rl0 = wr * 64 + fr, row0 = u.pm * BM + rl0, cl0 = wc * 32 + 8 * fq;
        if (pn < 4) {
#pragma unroll
            for (int ai = 0; ai < 2; ++ai)
#pragma unroll
                for (int m = 0; m < 4; ++m) { bf16_t* rowp = U + (size_t)(row0 + ai * HALF + m * 16) * POOLW + pn * BM + cl0;
#pragma unroll
                    for (int bj = 0; bj < 2; ++bj) *(u32x4*)(rowp + bj * HALF) = pack8(acc[ai][bj][m][0], acc[ai][bj][m][1]); }
            return;
        }
        const bool kpe_tile = (pn == 7);
#pragma unroll
        for (int ai = 0; ai < 2; ++ai)
#pragma unroll
            for (int m = 0; m < 4; ++m) {
                float s = sq4(acc[ai][0][m][0]) + sq4(acc[ai][0][m][1]);
                if (kpe_tile) { if (wc >= 2) s = 0.f; } else s += sq4(acc[ai][1][m][0]) + sq4(acc[ai][1][m][1]);
                s = fq_sum(s);
                if (fq == 0) part[(ai * HALF + rl0 + m * 16) * 4 + wc] = s;
            }
        lds_bar();
        if (pn < 6) {
#pragma unroll
            for (int ai = 0; ai < 2; ++ai)
#pragma unroll
                for (int m = 0; m < 4; ++m) { const int rl = ai * HALF + rl0 + m * 16, row = u.pm * BM + rl;
                    bf16_t* rowp = CQ + (size_t)row * QLORA + (pn - 4) * BM + cl0;
#pragma unroll
                    for (int bj = 0; bj < 2; ++bj) *(u32x4*)(rowp + bj * HALF) = pack8(acc[ai][bj][m][0], acc[ai][bj][m][1]);
                    if (wc == 0 && fq == 0) { const f32x4 p4 = *(const EPI_LAS f32x4*)(part + rl * 4); SSQQ[(pn - 4) * NTOK + row] = (p4[0] + p4[1]) + (p4[2] + p4[3]); } }
        } else if (pn == 6) {
            f32x4 gv[2][2];
#pragma unroll
            for (int bj = 0; bj < 2; ++bj)
#pragma unroll
                for (int n = 0; n < 2; ++n) gv[bj][n] = *(const f32x4*)(kv_a_g + bj * HALF + cl0 + 4 * n);
#pragma unroll
            for (int ai = 0; ai < 2; ++ai)
#pragma unroll
                for (int m = 0; m < 4; ++m) { const int rl = ai * HALF + rl0 + m * 16, row = u.pm * BM + rl;
                    const f32x4 p4 = *(const EPI_LAS f32x4*)(part + rl * 4); const float rstd = 1.0f / sqrtf(((p4[0] + p4[1]) + (p4[2] + p4[3])) * (1.0f / KVLORA) + EPSN);
                    bf16_t* rowp = CKVN + (size_t)kvrow_of(row) * KVLORA + cl0;
#pragma unroll
                    for (int bj = 0; bj < 2; ++bj) { const f32x4 v0 = acc[ai][bj][m][0] * rstd * gv[bj][0], v1 = acc[ai][bj][m][1] * rstd * gv[bj][1];
                        *(u32x4*)(rowp + bj * HALF) = pack8(v0, v1);
                        if (row < NCTX) { float* op = out_ckv + (size_t)row * KVLORA + bj * HALF + cl0; *(f32x4*)op = v0; *(f32x4*)(op + 4) = v1; } } }
        } else {
            const bool lat = (u.pm >= NCTX / BM);
            if (wc < 2) {
                f32x4 gv[2];
#pragma unroll
                for (int n = 0; n < 2; ++n) gv[n] = *(const f32x4*)(k_norm_g + DNOPE + cl0 + 4 * n);
#pragma unroll
                for (int ai = 0; ai < 2; ++ai)
#pragma unroll
                    for (int m = 0; m < 4; ++m) { const int rl = ai * HALF + rl0 + m * 16, row = u.pm * BM + rl, kr = kvrow_of(row);
#pragma unroll
                        for (int n = 0; n < 2; ++n) { f32x4 w = acc[ai][0][m][n] * gv[n];
                            if (lat) { const int t = (row - NCTX) & (LAT_T - 1); w = rope4(w, tab, wc == 0 ? (t >> 6) : (t & 63), fq, n); }
                            else *(f32x4*)(out_kpe + (size_t)row * ROPED + cl0 + 4 * n) = acc[ai][0][m][n];
                            *(f32x4*)(KPW + (size_t)kr * ROPED + cl0 + 4 * n) = w; }
                        if (wc == 0 && fq == 0) { const f32x4 p4 = *(const EPI_LAS f32x4*)(part + rl * 4); SSQK[kr] = (p4[0] + p4[1]) + (p4[2] + p4[3]); } }
            }
        }
    }
};

struct EpiQ {
    static constexpr bool PERM = true;
    bf16_t* Q; const float* SSQQ; const float* q_norm_g; const float* tab;
    __device__ __forceinline__ void operator()(f32x4 (&acc)[2][2][4][2], const Unit& u, int wr, int wc, int fr, int fq, EPI_LAS float* part) const {
        const int h = u.pn, rl0 = wr * 64 + fr, cl0 = wc * 32 + 8 * fq; const bool lat = (u.pm >= NCTX / BM), v1ok = (wc < 2);
#pragma unroll
        for (int ai = 0; ai < 2; ++ai)
#pragma unroll
            for (int m = 0; m < 4; ++m) { const int rl = ai * HALF + rl0 + m * 16, row = u.pm * BM + rl;
                const float rc = 1.0f / sqrtf((SSQQ[row] + SSQQ[NTOK + row]) * (1.0f / QLORA) + EPSN);
#pragma unroll
                for (int bj = 0; bj < 2; ++bj)
#pragma unroll
                    for (int n = 0; n < 2; ++n) acc[ai][bj][m][n] = acc[ai][bj][m][n] * rc;
                float s = sq4(acc[ai][0][m][0]) + sq4(acc[ai][0][m][1]);
                if (v1ok) s += sq4(acc[ai][1][m][0]) + sq4(acc[ai][1][m][1]);
                s = fq_sum(s);
                if (fq == 0) part[rl * 4 + wc] = s;
            }
        lds_bar();
        f32x4 gv[2][2];
#pragma unroll
        for (int bj = 0; bj < 2; ++bj)
#pragma unroll
            for (int n = 0; n < 2; ++n) gv[bj][n] = (bj == 0 || v1ok) ? *(const f32x4*)(q_norm_g + bj * HALF + cl0 + 4 * n) : (f32x4){0.f, 0.f, 0.f, 0.f};
#pragma unroll
        for (int ai = 0; ai < 2; ++ai)
#pragma unroll
            for (int m = 0; m < 4; ++m) { const int rl = ai * HALF + rl0 + m * 16, row = u.pm * BM + rl;
                const f32x4 p4 = *(const EPI_LAS f32x4*)(part + rl * 4); const float rn = 1.0f / sqrtf(((p4[0] + p4[1]) + (p4[2] + p4[3])) * (1.0f / DQK) + EPSN);
                bf16_t* rowp = Q + (size_t)row * (NH * DQK) + h * DQK + cl0;
                *(u32x4*)rowp = pack8(acc[ai][0][m][0] * rn * gv[0][0], acc[ai][0][m][1] * rn * gv[0][1]);
                if (v1ok) { f32x4 w0 = acc[ai][1][m][0] * rn * gv[1][0], w1 = acc[ai][1][m][1] * rn * gv[1][1];
                    if (lat) { const int t = (row - NCTX) & (LAT_T - 1), pos = (wc == 0) ? (t >> 6) : (t & 63); w0 = rope4(w0, tab, pos, fq, 0); w1 = rope4(w1, tab, pos, fq, 1); }
                    *(u32x4*)(rowp + HALF) = pack8(w0, w1); } }
    }
};

#define EPI_PIN(x) asm volatile("" : "+v"(x))
#define EPI_FENCE() asm volatile("" ::: "memory")
struct EpiKV {
    static constexpr bool PERM = true;
    bf16_t* Kb; bf16_t* Vb; const float* SSQK; const float* KPW; const float* k_norm_g;
    __device__ __forceinline__ void operator()(const f32x4 (&acc)[2][2][4][2], const Unit& u, int wr, int wc, int fr, int fq, EPI_LAS float* part) const {
        const int h = u.pn, rl0 = wr * 64 + fr, cl0 = wc * 32 + 8 * fq, e = 16 * wc + 4 * fq;
        float sk[4]; f32x4 kw[4];
        int kr0 = u.pm * BM + rl0; EPI_PIN(kr0);
#pragma unroll
        for (int m = 0; m < 4; ++m) { const int kr = kr0 + m * 16; sk[m] = SSQK[kr]; kw[m] = *(const f32x4*)(KPW + (size_t)kr * ROPED + e); }
#pragma unroll
        for (int ai = 0; ai < 2; ++ai)
#pragma unroll
            for (int m = 0; m < 4; ++m) { float s = sq4(acc[ai][0][m][0]) + sq4(acc[ai][0][m][1]); s = fq_sum(s); if (fq == 0) part[(ai * HALF + rl0 + m * 16) * 4 + wc] = s; }
        lds_bar();
        f32x4 gv[2];
#pragma unroll
        for (int n = 0; n < 2; ++n) gv[n] = *(const f32x4*)(k_norm_g + cl0 + 4 * n);
#pragma unroll
        for (int ai = 0; ai < 2; ++ai) {
            if (ai == 1) { int kr1 = u.pm * BM + HALF + rl0; EPI_PIN(kr1);
#pragma unroll
                for (int m = 0; m < 4; ++m) { const int kr = kr1 + m * 16; sk[m] = SSQK[kr]; kw[m] = *(const f32x4*)(KPW + (size_t)kr * ROPED + e); } }
#pragma unroll
            for (int m = 0; m < 4; ++m) { const int rl = ai * HALF + rl0 + m * 16; int kr = u.pm * BM + rl; EPI_PIN(kr);
                const f32x4 p4 = *(const EPI_LAS f32x4*)(part + rl * 4); const float rk = 1.0f / sqrtf((((p4[0] + p4[1]) + (p4[2] + p4[3])) + sk[m]) * (1.0f / DQK) + EPSN);
                bf16_t* kp = Kb + (size_t)kr * (NH * DQK) + h * DQK;
                *(u32x4*)(kp + cl0) = pack8(acc[ai][0][m][0] * rk * gv[0], acc[ai][0][m][1] * rk * gv[1]);
                *(u32x4*)(Vb + (size_t)kr * (NH * DVH) + h * DVH + cl0) = pack8(acc[ai][1][m][0], acc[ai][1][m][1]);
                const f32x4 kv = kw[m] * rk;
                u32x2 w; w.x = cvt_pk_bf16(kv[0], kv[1]); w.y = cvt_pk_bf16(kv[2], kv[3]); *(u32x2*)(kp + DNOPE + e) = w;
                EPI_FENCE(); }
        }
    }
};

template <int CTRL> __device__ __forceinline__ float dpp_upd(float old, float src) {
    return __builtin_bit_cast(float, __builtin_amdgcn_update_dpp(__builtin_bit_cast(int, old), __builtin_bit_cast(int, src), CTRL, 0xf, 0xf, false)); }
struct EpiUpConv {
    static constexpr bool PERM = true;
    bf16_t* G; float* EDGE; const float* conv_w; const float* conv_b;
    __device__ __forceinline__ void operator()(const f32x4 (&acc)[2][2][4][2], const Unit& u, int wr, int wc, int fr, int fq, EPI_LAS float* E) const {
        const int cl0 = wc * 32 + 8 * fq;
#pragma unroll
        for (int ai = 0; ai < 2; ++ai) { const int rb = 2 * ai + wr;
            if (fr == 0) {
#pragma unroll
                for (int ab = 0; ab < 2; ++ab)
#pragma unroll
                    for (int n = 0; n < 2; ++n) *(EPI_LAS f32x4*)(E + ((rb * 2 + 0) * 2 + ab) * 128 + cl0 + 4 * n) = acc[ai][ab][0][n]; }
            if (fr == 15) {
#pragma unroll
                for (int ab = 0; ab < 2; ++ab)
#pragma unroll
                    for (int n = 0; n < 2; ++n) *(EPI_LAS f32x4*)(E + ((rb * 2 + 1) * 2 + ab) * 128 + cl0 + 4 * n) = acc[ai][ab][3][n]; } }
        lds_bar();
        const bool lat = (u.pm >= NCTX / BM);
#pragma unroll
        for (int n = 0; n < 2; ++n) {
            int c = u.pn * HALF + cl0 + 4 * n; EPI_PIN(c);
            f32x4 w[2][3], bs[2];
#pragma unroll
            for (int ab = 0; ab < 2; ++ab) { bs[ab] = *(const f32x4*)(conv_b + ab * DFF + c);
#pragma unroll
                for (int k = 0; k < 3; ++k) w[ab][k] = *(const f32x4*)(conv_w + (size_t)k * (2 * DFF) + ab * DFF + c); }
#pragma unroll
            for (int ai = 0; ai < 2; ++ai) { const int rb = 2 * ai + wr;
                f32x4 z[2][4];
#pragma unroll
                for (int ab = 0; ab < 2; ++ab) {
                    f32x4 pe = {0.f, 0.f, 0.f, 0.f}, ne = pe;
                    if (rb > 0) pe = *(const EPI_LAS f32x4*)(E + (((rb - 1) * 2 + 1) * 2 + ab) * 128 + cl0 + 4 * n);
                    if (rb < 3) ne = *(const EPI_LAS f32x4*)(E + (((rb + 1) * 2 + 0) * 2 + ab) * 128 + cl0 + 4 * n);
                    f32x4 mir[4];
#pragma unroll
                    for (int m = 0; m < 4; ++m)
#pragma unroll
                        for (int j = 0; j < 4; ++j) mir[m][j] = dpp_upd<0x140>(0.f, acc[ai][ab][m][n][j]);
#pragma unroll
                    for (int m = 0; m < 4; ++m)
#pragma unroll
                        for (int j = 0; j < 4; ++j) { const float v = acc[ai][ab][m][n][j];
                            const float prev = dpp_upd<0x111>(m > 0 ? mir[m - 1][j] : pe[j], v);
                            const float next = dpp_upd<0x101>(m < 3 ? mir[m + 1][j] : ne[j], v);
                            z[ab][m][j] = w[ab][0][j] * prev + w[ab][1][j] * v + w[ab][2][j] * next + bs[ab][j]; }
                }
#pragma unroll
                for (int m = 0; m < 4; ++m) { int row = u.pm * BM + ai * HALF + wr * 64 + m * 16 + fr; EPI_PIN(row);
                    f32x4 gq;
#pragma unroll
                    for (int j = 0; j < 4; ++j) { const float za = z[0][m][j]; gq[j] = za * __builtin_amdgcn_rcpf(1.0f + __expf(-za)) * z[1][m][j]; }
                    u32x2 o; o.x = cvt_pk_bf16(gq[0], gq[1]); o.y = cvt_pk_bf16(gq[2], gq[3]);
                    *(u32x2*)(G + (size_t)row * DFF + c) = o; }
                if (lat) {
                    if (ai == 0 && wr == 0 && fr == 0) {
#pragma unroll
                        for (int ab = 0; ab < 2; ++ab) { *(f32x4*)(EDGE + ((size_t)(u.pm * 4 + 0) * 2 + ab) * DFF + c) = z[ab][0]; *(f32x4*)(EDGE + ((size_t)(u.pm * 4 + 2) * 2 + ab) * DFF + c) = acc[0][ab][0][n]; } }
                    if (ai == 1 && wr == 1 && fr == 15) {
#pragma unroll
                        for (int ab = 0; ab < 2; ++ab) { *(f32x4*)(EDGE + ((size_t)(u.pm * 4 + 1) * 2 + ab) * DFF + c) = z[ab][3]; *(f32x4*)(EDGE + ((size_t)(u.pm * 4 + 3) * 2 + ab) * DFF + c) = acc[1][ab][3][n]; } }
                }
                EPI_FENCE();
            }
        }
    }
};

struct EpiGateRes {
    static constexpr bool PERM = false;
    const float* base_ctx; const float* base_lat; float* out; const float* gate;
    __device__ __forceinline__ void operator()(const f32x4 (&acc)[2][2][4][2], const Unit& u, int wr, int wc, int fr, int fq, EPI_LAS float*) const {
        const int cond = (u.pm < NCTX / BM) ? 0 : 1 + (u.pm - NCTX / BM) / (LAT_T / BM);
        const int col0 = u.pn * BM + wc * 32 + 4 * fq; const float* gp = gate + (size_t)cond * (NMOD * DM) + col0;
        f32x4 gv[2][2];
#pragma unroll
        for (int bj = 0; bj < 2; ++bj)
#pragma unroll
            for (int n = 0; n < 2; ++n) gv[bj][n] = *(const f32x4*)(gp + bj * HALF + n * 16);
        const float* base = (u.pm < NCTX / BM) ? base_ctx : base_lat - (size_t)NCTX * DM;
#pragma unroll
        for (int ai = 0; ai < 2; ++ai)
#pragma unroll
            for (int m = 0; m < 4; ++m) { const size_t off = (size_t)(u.pm * BM + ai * HALF + wr * 64 + m * 16 + fr) * DM + col0;
#pragma unroll
                for (int bj = 0; bj < 2; ++bj)
#pragma unroll
                    for (int n = 0; n < 2; ++n) { const f32x4 bs = *(const f32x4*)(base + off + bj * HALF + n * 16); *(f32x4*)(out + off + bj * HALF + n * 16) = bs + gv[bj][n] * acc[ai][bj][m][n]; }
                if (m & 1) asm volatile("" ::: "memory"); }
    }
};
}
namespace att {
using bf16 = unsigned short;
constexpr int DQ = 192, DVV = 128, NW = 8, QBLK = 32, KVBLK = 64;
constexpr float SCALE = 0.07216878364870322f;
constexpr float THR = 8.f;
constexpr int LDQ = 8 * DQ, LDKK = 8 * DQ, LDVV = 8 * DVV, LDO = 2048;
constexpr int SHM_V = KVBLK * DVV * 2, SHM_K = KVBLK * DQ * 2, NQR = 6  , SHM_QR = NW * (12 - NQR) * 1024, SHM_ATTN = 2 * SHM_V + 2 * SHM_K + NW * 64 * 4 + SHM_QR;
using bf16x8 = __attribute__((ext_vector_type(8))) short;
using s16x4  = __attribute__((ext_vector_type(4))) short;
using f32x16 = __attribute__((ext_vector_type(16))) float;
using u32x4  = __attribute__((ext_vector_type(4))) unsigned;
#define KSWZ(row, colB) ((row) * 384 + ((colB) ^ ((((row) >> 1) & 7) << 4)))
#define SBAR() __builtin_amdgcn_sched_barrier(0)
__device__ __forceinline__ int crow(int r, int hi) { return (r & 3) + 8 * (r >> 2) + 4 * hi; }
__device__ __forceinline__ unsigned cvtpk(float lo, float hi) { unsigned r; asm volatile("v_cvt_pk_bf16_f32 %0, %1, %2" : "=v"(r) : "v"(lo), "v"(hi)); return r; }

__device__ __forceinline__ void partialSM(f32x16& p0, f32x16& p1, float& m_reg, float& mn, float& alpha) {
  constexpr float C = SCALE * 1.4426950408889634f;
  float pmax = p0[0];
#pragma unroll
  for (int r = 1; r < 16; ++r) pmax = fmaxf(pmax, p0[r]);
#pragma unroll
  for (int r = 0; r < 16; ++r) pmax = fmaxf(pmax, p1[r]);
  { auto rr = __builtin_amdgcn_permlane32_swap(__float_as_uint(pmax), __float_as_uint(pmax), false, false);
    pmax = fmaxf(__uint_as_float(rr[0]), __uint_as_float(rr[1])); }
  if (__builtin_expect(__all(pmax - m_reg <= THR / SCALE), 1)) { mn = m_reg; alpha = 1.f; }
  else { mn = fmaxf(m_reg, pmax); alpha = __builtin_amdgcn_exp2f((m_reg - mn) * C); m_reg = mn; }
  float mnC = -mn * C;
#pragma unroll
  for (int r = 0; r < 16; ++r) p0[r] = fmaf(p0[r], C, mnC);
#pragma unroll
  for (int r = 0; r < 16; ++r) p1[r] = fmaf(p1[r], C, mnC);
#pragma unroll
  for (int r = 0; r < 16; ++r) p0[r] = __builtin_amdgcn_exp2f(p0[r]);
}
__device__ __forceinline__ void finishSM(f32x16& p0, f32x16& p1, float alpha, float& l_reg, bf16x8& pa0, bf16x8& pa1, bf16x8& pa2, bf16x8& pa3) {
#pragma unroll
  for (int r = 0; r < 16; ++r) p1[r] = __builtin_amdgcn_exp2f(p1[r]);
  float ps = 0;
#pragma unroll
  for (int r = 0; r < 16; ++r) ps += p0[r];
#pragma unroll
  for (int r = 0; r < 16; ++r) ps += p1[r];
  { auto rr = __builtin_amdgcn_permlane32_swap(__float_as_uint(ps), __float_as_uint(ps), false, false);
    ps = __uint_as_float(rr[0]) + __uint_as_float(rr[1]); }
  l_reg = l_reg * alpha + ps;
#define PK4(P, BASE, OUT) do { unsigned a0 = cvtpk(P[BASE + 0], P[BASE + 1]), a1 = cvtpk(P[BASE + 2], P[BASE + 3]);   \
    unsigned b0 = cvtpk(P[BASE + 4], P[BASE + 5]), b1 = cvtpk(P[BASE + 6], P[BASE + 7]);                              \
    auto r0 = __builtin_amdgcn_permlane32_swap(a0, b0, false, false); auto r1 = __builtin_amdgcn_permlane32_swap(a1, b1, false, false); \
    u32x4 w = {r0[0], r1[0], r0[1], r1[1]}; OUT = *reinterpret_cast<bf16x8*>(&w); } while (0)
  PK4(p0, 0, pa0); PK4(p0, 8, pa1); PK4(p1, 0, pa2); PK4(p1, 8, pa3);
#undef PK4
}
__device__ __forceinline__ void qkt(f32x16& p0, f32x16& p1, const char* Ks, const bf16x8* qr, const char* qw, int r32, int hi) {
  p0 = f32x16{}; p1 = f32x16{};
#pragma unroll
  for (int d0 = 0; d0 < 12; ++d0) { int cb = (d0 * 16 + hi * 8) * 2;
    bf16x8 b0 = *reinterpret_cast<const bf16x8*>(Ks + KSWZ(r32, cb));
    bf16x8 b1 = *reinterpret_cast<const bf16x8*>(Ks + KSWZ(32 + r32, cb));
    const bf16x8 qf = (d0 < NQR) ? qr[d0 < NQR ? d0 : 0] : *reinterpret_cast<const bf16x8*>(qw + (d0 - NQR) * 1024);
    p0 = __builtin_amdgcn_mfma_f32_32x32x16_bf16(b0, qf, p0, 0, 0, 0);
    p1 = __builtin_amdgcn_mfma_f32_32x32x16_bf16(b1, qf, p1, 0, 0, 0); }
}
__device__ __forceinline__ int v_st(int k, int c) { const int kk = (k & ~0xC) | ((k & 4) << 1) | ((k & 8) >> 1); return ((kk >> 3) * 4 + (c >> 5)) * 512 + ((kk & 7) * 32 + (c & 31)) * 2; }
__device__ __forceinline__ int v_rd_base(int lane) { return ((lane & 3) << 3) | (((lane >> 2) & 3) << 6) | (((lane >> 4) & 1) << 5) | (((lane >> 5) & 1) << 8); }
constexpr int v_rd_off(int d0, int ks, int half) { return d0 * 512 + ks * 4096 + half * 2048; }
template <int OFF> __device__ __forceinline__ s16x4 tr_read(int vb) {
  s16x4 r; asm volatile("ds_read_b64_tr_b16 %0, %1 offset:%2" : "=&v"(r) : "v"(vb), "i"(OFF) : "memory"); return r;
}
template <int D0> __device__ __forceinline__ void pv_one(f32x16& od, int vb, bf16x8 pa0, bf16x8 pa1, bf16x8 pa2, bf16x8 pa3) {
  const s16x4 l0 = tr_read<v_rd_off(D0, 0, 0)>(vb), h0 = tr_read<v_rd_off(D0, 0, 1)>(vb), l1 = tr_read<v_rd_off(D0, 1, 0)>(vb), h1 = tr_read<v_rd_off(D0, 1, 1)>(vb);
  const s16x4 l2 = tr_read<v_rd_off(D0, 2, 0)>(vb), h2 = tr_read<v_rd_off(D0, 2, 1)>(vb), l3 = tr_read<v_rd_off(D0, 3, 0)>(vb), h3 = tr_read<v_rd_off(D0, 3, 1)>(vb);
  asm volatile("s_waitcnt lgkmcnt(0)" ::: "memory"); SBAR();
#define PK(L, H) (bf16x8){L[0], L[1], L[2], L[3], H[0], H[1], H[2], H[3]}
  od = __builtin_amdgcn_mfma_f32_32x32x16_bf16(pa0, PK(l0, h0), od, 0, 0, 0);
  od = __builtin_amdgcn_mfma_f32_32x32x16_bf16(pa1, PK(l1, h1), od, 0, 0, 0);
  od = __builtin_amdgcn_mfma_f32_32x32x16_bf16(pa2, PK(l2, h2), od, 0, 0, 0);
  od = __builtin_amdgcn_mfma_f32_32x32x16_bf16(pa3, PK(l3, h3), od, 0, 0, 0);
#undef PK
}
__device__ __forceinline__ void pv_d0(f32x16* o, int vb, bf16x8 pa0, bf16x8 pa1, bf16x8 pa2, bf16x8 pa3) {
  pv_one<0>(o[0], vb, pa0, pa1, pa2, pa3); pv_one<1>(o[1], vb, pa0, pa1, pa2, pa3); pv_one<2>(o[2], vb, pa0, pa1, pa2, pa3); pv_one<3>(o[3], vb, pa0, pa1, pa2, pa3);
}

struct Split { float* part; float* stats; unsigned* cnt; int slot; int half; };
template <bool SPLIT>
__device__ __forceinline__ void attn_dense_body(const bf16* __restrict__ Qb, const bf16* __restrict__ Kh, const bf16* __restrict__ Vh, bf16* __restrict__ Ob, int seq, char* lds, const Split sp) {
  int tid_ = threadIdx.x; asm volatile("" : "+v"(tid_));
  const int tid = tid_, wid = tid >> 6, lane = tid & 63, r32 = lane & 31, hi = lane >> 5;
  char* V_lds = lds; char* K_lds = lds + 2 * SHM_V;
  float* ws = (float*)(lds + 2 * SHM_V + 2 * SHM_K) + wid * 64; float* li_l = ws; float* al_l = ws + 32;
  float m_reg = -1e30f, l_reg = 0; f32x16 o[4] = {}; bf16x8 qr[NQR];
  char* qw = lds + 2 * SHM_V + 2 * SHM_K + NW * 64 * 4 + wid * ((12 - NQR) * 1024) + lane * 16;
  const bf16* Qw = Qb + (long)(wid * QBLK + r32) * LDQ + hi * 8;
#pragma unroll
  for (int d0 = 0; d0 < NQR; ++d0) qr[d0] = *reinterpret_cast<const bf16x8*>(Qw + d0 * 16);
#pragma unroll
  for (int d0 = NQR; d0 < 12; ++d0) *reinterpret_cast<bf16x8*>(qw + (d0 - NQR) * 1024) = *reinterpret_cast<const bf16x8*>(Qw + d0 * 16);
  const int sr = tid >> 4, sc = (tid & 15) * 8, vst0 = v_st(sr, sc), vst1 = v_st(32 + sr, sc);
  int kg[3], kl[3];
#pragma unroll
  for (int i = 0; i < 3; ++i) { const int q = tid + 512 * i, kr_ = q / 24, kc = q % 24; kg[i] = kr_ * LDKK + kc * 8; kl[i] = KSWZ(kr_, kc * 16); }
  const int vb0 = (int)(uintptr_t)V_lds + v_rd_base(lane);
  bf16x8 vs0, vs1, ks0, ks1, ks2;
#define SLOAD(k0) do { vs0 = *(const bf16x8*)(&Vh[(long)((k0) + sr) * LDVV + sc]); vs1 = *(const bf16x8*)(&Vh[(long)((k0) + 32 + sr) * LDVV + sc]); \
    ks0 = *(const bf16x8*)(&Kh[(long)(k0) * LDKK + kg[0]]); ks1 = *(const bf16x8*)(&Kh[(long)(k0) * LDKK + kg[1]]); ks2 = *(const bf16x8*)(&Kh[(long)(k0) * LDKK + kg[2]]); } while (0)
#define SWRITE(b) do { *(bf16x8*)(V_lds + (b) * SHM_V + vst0) = vs0; *(bf16x8*)(V_lds + (b) * SHM_V + vst1) = vs1; \
    *(bf16x8*)(K_lds + (b) * SHM_K + kl[0]) = ks0; *(bf16x8*)(K_lds + (b) * SHM_K + kl[1]) = ks1; *(bf16x8*)(K_lds + (b) * SHM_K + kl[2]) = ks2; } while (0)
#define RESC(a) do { if (__any((a) < 1.f)) { if (hi == 0) al_l[r32] = (a); asm volatile("s_waitcnt lgkmcnt(0)" ::: "memory"); \
    _Pragma("unroll") for (int d = 0; d < 4; ++d) _Pragma("unroll") for (int r = 0; r < 16; ++r) o[d][r] *= al_l[crow(r, hi)]; } } while (0)
  f32x16 pA0, pA1, pB0, pB1; float mnA, mnB, alA, alB; bf16x8 pa0, pa1, pa2, pa3; const int NT = seq / KVBLK;
  SLOAD(0); asm volatile("s_waitcnt vmcnt(0)" ::: "memory"); SWRITE(0); __syncthreads();
  qkt(pA0, pA1, K_lds, qr, qw, r32, hi); partialSM(pA0, pA1, m_reg, mnA, alA);
  SLOAD(KVBLK);
  asm volatile("s_waitcnt vmcnt(0)" ::: "memory"); SWRITE(1); __syncthreads();
  for (int j = 1; j + 1 < NT; j += 2) {
    SBAR(); qkt(pB0, pB1, K_lds + SHM_K, qr, qw, r32, hi);
    finishSM(pA0, pA1, alA, l_reg, pa0, pa1, pa2, pa3); SBAR();
    SLOAD((j + 1) * KVBLK); SBAR();
    pv_d0(o, vb0, pa0, pa1, pa2, pa3); partialSM(pB0, pB1, m_reg, mnB, alB);
    __syncthreads(); asm volatile("s_waitcnt vmcnt(0)" ::: "memory"); SWRITE(0);
    RESC(alB); __syncthreads();
    SBAR(); qkt(pA0, pA1, K_lds, qr, qw, r32, hi);
    finishSM(pB0, pB1, alB, l_reg, pa0, pa1, pa2, pa3); SBAR();
    SLOAD((j + 2) * KVBLK); SBAR();
    pv_d0(o, vb0 + SHM_V, pa0, pa1, pa2, pa3); partialSM(pA0, pA1, m_reg, mnA, alA);
    __syncthreads(); asm volatile("s_waitcnt vmcnt(0)" ::: "memory"); SWRITE(1);
    RESC(alA); __syncthreads();
  }
  SBAR(); qkt(pB0, pB1, K_lds + SHM_K, qr, qw, r32, hi);
  finishSM(pA0, pA1, alA, l_reg, pa0, pa1, pa2, pa3); SBAR();
  pv_d0(o, vb0, pa0, pa1, pa2, pa3); partialSM(pB0, pB1, m_reg, mnB, alB);
  __syncthreads(); RESC(alB);
  finishSM(pB0, pB1, alB, l_reg, pa0, pa1, pa2, pa3); SBAR();
  pv_d0(o, vb0 + SHM_V, pa0, pa1, pa2, pa3);
  bf16* Ow = Ob + (long)(wid * QBLK) * LDO;
  if constexpr (!SPLIT) {
    if (hi == 0) li_l[r32] = l_reg; asm volatile("s_waitcnt lgkmcnt(0)" ::: "memory");
    float rli[16];
#pragma unroll
    for (int r = 0; r < 16; ++r) rli[r] = __builtin_amdgcn_rcpf(li_l[crow(r, hi)]);
#pragma unroll
    for (int r = 0; r < 16; ++r) { const int orow = crow(r, hi);
#pragma unroll
      for (int d0 = 0; d0 < 4; ++d0) { const float v = o[d0][r] * rli[r]; Ow[(long)orow * LDO + d0 * 32 + r32] = (bf16)(cvtpk(v, v) & 0xffffu); } }
    __syncthreads();
  } else {
    typedef float f32x4_t __attribute__((ext_vector_type(4)));
    constexpr float C = SCALE * 1.4426950408889634f;
    float* pmine = sp.part + (size_t)sp.slot * 32768 + wid * 4096 + lane * 4;
#pragma unroll
    for (int d0 = 0; d0 < 4; ++d0)
#pragma unroll
      for (int rq = 0; rq < 4; ++rq) *(f32x4_t*)(pmine + (d0 * 4 + rq) * 256) = (f32x4_t){o[d0][4 * rq], o[d0][4 * rq + 1], o[d0][4 * rq + 2], o[d0][4 * rq + 3]};
    if (hi == 0) { float* st = sp.stats + ((size_t)sp.slot * 256 + wid * 32 + r32) * 2; st[0] = m_reg; st[1] = l_reg; }
    unsigned* flag = (unsigned*)(lds + SHM_ATTN);
    asm volatile("s_waitcnt vmcnt(0)" ::: "memory");
    __syncthreads();
    if (tid == 0) {
      __builtin_amdgcn_fence(__ATOMIC_RELEASE, "agent"); asm volatile("s_waitcnt vmcnt(0)" ::: "memory");
      const unsigned old = __hip_atomic_fetch_add(sp.cnt, 1u, __ATOMIC_RELAXED, __HIP_MEMORY_SCOPE_AGENT);
      if (old == 1u) { __builtin_amdgcn_fence(__ATOMIC_ACQUIRE, "agent"); asm volatile("s_waitcnt vmcnt(0)" ::: "memory"); }
      *flag = old;
    }
    __syncthreads();
    if (*flag == 1u) {
      const int pslot = sp.slot ^ 1;
      const float* st = sp.stats + ((size_t)pslot * 256 + wid * 32 + r32) * 2; const float m_p = st[0], l_p = st[1];
      const float m0 = sp.half ? m_p : m_reg, l0 = sp.half ? l_p : l_reg, m1 = sp.half ? m_reg : m_p, l1 = sp.half ? l_reg : l_p;
      const float mm = fmaxf(m0, m1), a0 = __builtin_amdgcn_exp2f((m0 - mm) * C), a1 = __builtin_amdgcn_exp2f((m1 - mm) * C);
      const float L = fmaf(a1, l1, a0 * l0), iL = 1.0f / L;
      if (hi == 0) { li_l[r32] = a0 * iL; al_l[r32] = a1 * iL; } asm volatile("s_waitcnt lgkmcnt(0)" ::: "memory");
      const float* ppar = sp.part + (size_t)pslot * 32768 + wid * 4096 + lane * 4;
#pragma unroll
      for (int rq = 0; rq < 4; ++rq) {
        f32x4_t po[4];
#pragma unroll
        for (int d0 = 0; d0 < 4; ++d0) po[d0] = *(const f32x4_t*)(ppar + (d0 * 4 + rq) * 256);
#pragma unroll
        for (int e = 0; e < 4; ++e) { const int r = 4 * rq + e, orow = crow(r, hi); const float f0 = li_l[orow], f1 = al_l[orow];
#pragma unroll
          for (int d0 = 0; d0 < 4; ++d0) { const float x0 = sp.half ? po[d0][e] : o[d0][r], x1 = sp.half ? o[d0][r] : po[d0][e];
            const float v = fmaf(x1, f1, x0 * f0); Ow[(long)orow * LDO + d0 * 32 + r32] = (bf16)(cvtpk(v, v) & 0xffffu); } }
      }
    }
    __syncthreads();
  }
#undef SLOAD
#undef SWRITE
#undef RESC
}
#undef KSWZ
#undef SBAR
}
#ifndef MK_N_LAUNCHES
#define MK_N_LAUNCHES 1
#endif
constexpr int NWAVES = 8;
constexpr int N_PHASES = 10;
#ifndef MK_DUP
#define MK_DUP 0
#endif
constexpr int N_LAUNCHES = MK_N_LAUNCHES;

constexpr size_t MiB = 1u << 20;
constexpr size_t WS_CTL = 0, CTL_ZERO_BYTES = 1 * MiB;
constexpr size_t WS_MODP = 1 * MiB;
constexpr size_t WS_MOD = WS_MODP + 640 * 1024;
constexpr size_t WS_TAB = WS_MOD + 160 * 1024;
constexpr size_t WS_SSQQ = 2 * MiB;
constexpr size_t WS_SSQK = WS_SSQQ + 64 * 1024;
constexpr size_t WS_KPW = 3 * MiB;
constexpr size_t WS_WIN = 8 * MiB;
constexpr size_t WS_WPOOL = 16 * MiB;
constexpr size_t WS_WUQ = 17 * MiB;
constexpr size_t WS_WUKV = 19 * MiB;
constexpr size_t WS_WOUT = 20 * MiB;
constexpr size_t WS_WUP = 28 * MiB;
constexpr size_t WS_WDOWN = 72 * MiB;
constexpr size_t WS_G = 190 * MiB;
constexpr size_t WS_H = 94 * MiB;
constexpr size_t WS_U = 126 * MiB;
constexpr size_t WS_PV = 142 * MiB;
constexpr size_t WS_CQ = 158 * MiB;
constexpr size_t WS_CKVN = 166 * MiB;
constexpr size_t WS_UP = 182 * MiB;
constexpr size_t WS_Q = 182 * MiB;
constexpr size_t WS_K = 206 * MiB;
constexpr size_t WS_V = 233 * MiB;
constexpr size_t WS_MIX = 251 * MiB;
constexpr size_t WS_EDGE = 182 * MiB;
constexpr size_t WS_END = 358 * MiB;
static_assert(WS_G + (size_t)NTOK * DFF * 2 <= WS_END && WS_EDGE + (size_t)32 * 4 * 2 * DFF * 4 <= WS_G && WS_CKVN + (size_t)KVROWS * KVLORA * 2 <= WS_UP && WS_MIX + (size_t)NTOK * DM * 2 <= WS_END && WS_UP + (size_t)NTOK * 2 * DFF * 2 <= WS_END, "d_ws map");
constexpr int CW_BAR = 4096;
constexpr int CW_ATT = 16384;
constexpr size_t WS_APART = 94 * MiB;
constexpr size_t WS_ASTAT = 126 * MiB;

constexpr int RING_BYTES = 131072, SX_OFF = 139264  , MISC_OFF = SX_OFF + 8192, LDS_BYTES = 151552;
static_assert(att::SHM_ATTN + 16 <= SX_OFF && MISC_OFF + 256 <= LDS_BYTES, "LDS map");

#define GAS __attribute__((address_space(1)))
#define LAS __attribute__((address_space(3)))
typedef unsigned short bf16;
typedef unsigned v4u __attribute__((ext_vector_type(4)));
typedef unsigned v2u __attribute__((ext_vector_type(2)));
typedef float f32x4 __attribute__((ext_vector_type(4)));
typedef short bf16x8 __attribute__((ext_vector_type(8)));
#define LDS_WAIT() asm volatile("s_waitcnt lgkmcnt(0)" ::: "memory")
__device__ __forceinline__ unsigned f2bf(float f) { unsigned u = __builtin_bit_cast(unsigned, f); return (u + 0x7fffu + ((u >> 16) & 1u)) >> 16; }
__device__ __forceinline__ unsigned pk2(float lo, float hi) { return f2bf(lo) | (f2bf(hi) << 16); }
__device__ __forceinline__ float bflo(unsigned w) { return __builtin_bit_cast(float, w << 16); }
__device__ __forceinline__ float bfhi(unsigned w) { return __builtin_bit_cast(float, w & 0xffff0000u); }

#define XB_TMO      128
#define XB_XCNT(j)  (256  + 64 * (j))
#define XB_XSUB(j)  (1280 + 64 * (j))
#define XB_XGEN(j)  (2304 + 64 * (j))
#define XB_TOP      3328
#define XB_TOPGEN   3392
#define XCD_BAR_WORDS 3456
#define XB_SPIN_CAP (1u << 18)
__device__ __forceinline__ unsigned xb_ld(unsigned* p)              { return __hip_atomic_load(p, __ATOMIC_RELAXED, __HIP_MEMORY_SCOPE_AGENT); }
__device__ __forceinline__ unsigned xb_add(unsigned* p, unsigned v) { return __hip_atomic_fetch_add(p, v, __ATOMIC_RELAXED, __HIP_MEMORY_SCOPE_AGENT); }
__device__ __forceinline__ unsigned xb_xcc_id() { return (unsigned)__builtin_amdgcn_s_getreg((3 << 11) | 20) & 0xFu; }
#define XB_SPIN(cond, bar) do { unsigned _sp = 0; while (cond) { __builtin_amdgcn_s_sleep(1); \
    if ((++_sp & 255u) == 0u) { if (xb_ld(&(bar)[XB_TMO])) break; if (_sp > XB_SPIN_CAP) { atomicAdd(&(bar)[XB_TMO], 1u); break; } } } } while (0)
struct XcdBarrier { unsigned* bar; unsigned x; volatile LAS unsigned* st; };
__device__ __forceinline__ XcdBarrier xcd_barrier_post(unsigned* bar, volatile LAS unsigned* st) {
    XcdBarrier b; b.bar = bar; b.x = xb_xcc_id(); b.st = st;
    if (threadIdx.x == 0) (void)xb_add(&bar[XB_XCNT(b.x)], 1u);
    return b;
}
__device__ __forceinline__ void xcd_barrier_complete(unsigned* bar, unsigned x, unsigned& nloc, unsigned& nx) {
    const unsigned G = gridDim.x * gridDim.y * gridDim.z;
    unsigned sum, cnt, mine, sp = 0u;
    for (;;) {
        sum = 0u; cnt = 0u; mine = 0u;
#pragma unroll
        for (unsigned j = 0; j < 16; ++j) { const unsigned c = xb_ld(&bar[XB_XCNT(j)]); sum += c; cnt += (c > 0u) ? 1u : 0u; mine = (j == x) ? c : mine; }
        if (sum == G) break;
        __builtin_amdgcn_s_sleep(1);
        if ((++sp & 255u) == 0u) { if (xb_ld(&bar[XB_TMO])) break; if (sp > XB_SPIN_CAP) { atomicAdd(&bar[XB_TMO], 1u); break; } }
    }
    nloc = mine > 0u ? mine : 1u; nx = cnt > 0u ? cnt : 1u;
}
__device__ __forceinline__ void xcd_barrier(const XcdBarrier& b) {
    asm volatile("s_waitcnt vmcnt(0)" ::: "memory");
    __syncthreads();
    if (threadIdx.x == 0) {
        unsigned* bar = b.bar;
        __builtin_amdgcn_s_waitcnt(0);
        unsigned nloc = b.st[0], nx = b.st[1];
        if (nloc == 0u) { xcd_barrier_complete(bar, b.x, nloc, nx); b.st[0] = nloc; b.st[1] = nx; }
        const unsigned old = xb_add(&bar[XB_XSUB(b.x)], 1u);
        const unsigned gen = old / nloc;
        if (old + 1u == (gen + 1u) * nloc) {
            __builtin_amdgcn_fence(__ATOMIC_RELEASE, "agent");
            asm volatile("s_waitcnt vmcnt(0)" ::: "memory");
            const unsigned og = xb_add(&bar[XB_TOP], 1u);
            const unsigned tg = og / nx;
            if (og + 1u == (tg + 1u) * nx) xb_add(&bar[XB_TOPGEN], 1u);
            else XB_SPIN(xb_ld(&bar[XB_TOPGEN]) == tg, bar);
            __builtin_amdgcn_fence(__ATOMIC_ACQUIRE, "agent");
            xb_add(&bar[XB_XGEN(b.x)], 1u);
            asm volatile("s_waitcnt vmcnt(0)" ::: "memory");
        } else {
            XB_SPIN(xb_ld(&bar[XB_XGEN(b.x)]) == gen, bar);
            __builtin_amdgcn_fence(__ATOMIC_ACQUIRE, "agent");
            asm volatile("s_waitcnt vmcnt(0)" ::: "memory");
        }
    }
    __syncthreads();
}

struct Args {
    const float *x_prompt, *x_sample, *cache_ckv, *cache_kpe, *c, *c_ctx, *norm1_g, *norm2_g, *w_mod, *b_mod, *w_in, *w_pool, *pool_scale, *q_a_g, *w_uq, *kv_a_g, *w_ukv,
                *q_norm_g, *k_norm_g, *w_out, *w_up, *conv_w, *conv_b, *w_down;
    float* out; unsigned char* ws; int ph_lo, ph_hi, li, pad;
};
struct Frame {
    LAS unsigned char* lds; int tid, lane, wave, G, bid;
};
__device__ __forceinline__ float wave_sum(float v) {
#pragma unroll
    for (int o = 1; o < 64; o <<= 1) v += __shfl_xor(v, o);
    return v;
}
__device__ __forceinline__ float silu_f(float v) { return v / (1.0f + __expf(-v)); }

__device__ __forceinline__ void p0_transpose_item(const float* W, int N, int K, bf16* WT, int k0, int n0, int drow, const float* kscale, LAS float* scr, int lane) {
#pragma unroll 8
    for (int i = 0; i < 32; ++i) { const int kk = 2 * i + (lane >> 5); float v = W[(size_t)(k0 + kk) * N + n0 + (lane & 31)]; if (kscale) v *= kscale[k0 + kk]; scr[kk * 33 + (lane & 31)] = v; }
    LDS_WAIT(); asm volatile("" ::: "memory");
    const int c = lane & 7;
#pragma unroll
    for (int j = 0; j < 4; ++j) { const int n = (lane >> 3) + 8 * j; const LAS float* s = scr + (8 * c) * 33 + n;
        v4u o; o.x = pk2(s[0 * 33], s[1 * 33]); o.y = pk2(s[2 * 33], s[3 * 33]); o.z = pk2(s[4 * 33], s[5 * 33]); o.w = pk2(s[6 * 33], s[7 * 33]);
        *(GAS v4u*)(WT + (size_t)(drow + n) * K + k0 + 8 * c) = o; }
    LDS_WAIT(); asm volatile("" ::: "memory");
}
__device__ __forceinline__ void sincos_small(float x, float& s, float& c) {
    const double xd = (double)x; const double n = __builtin_rint(xd * 0.63661977236758134); const float r = (float)(xd - n * 1.5707963267948966); const int q = ((int)n) & 3;
    const float r2 = r * r;
    const float sp = r + r * r2 * (-1.6666667163e-01f + r2 * (8.3333337680e-03f + r2 * (-1.9841270114e-04f + r2 * 2.7557314297e-06f)));
    const float cp = 1.0f + r2 * (-0.5f + r2 * (4.1666667908e-02f + r2 * (-1.3888889225e-03f + r2 * (2.4801587642e-05f + r2 * -2.7557314297e-07f))));
    const float ss = (q & 1) ? cp : sp, cc = (q & 1) ? sp : cp;
    s = (q & 2) ? -ss : ss; c = ((q + 1) & 2) ? -cc : cc;
}

__device__ __forceinline__ void phase0(const Frame& F, const Args& a) {
    unsigned char* ws = a.ws;
    LAS float* sl = (LAS float*)F.lds;
    LAS float* red = sl + 3 * DM;
    for (int i = F.tid; i < 3 * DM; i += NWAVES * 64) { const int r = i / DM, k = i % DM; const float v = (r == 0) ? a.c_ctx[k] : a.c[(r - 1) * DM + k]; sl[i] = silu_f(v); }
    __syncthreads();
    float* MODP = (float*)(ws + WS_MODP);
    for (int task = F.bid; task < 768; task += F.G) {
        const int cb = task % 192, kq = task / 192, kbase = kq * 512 + F.wave * 64, rg = F.lane >> 4, cl = (F.lane & 15) * 4;
        f32x4 a0 = {0.f, 0.f, 0.f, 0.f}, a1 = a0, a2 = a0;
        const float* wp = a.w_mod + (size_t)(kbase + rg) * (NMOD * DM) + cb * 64 + cl;
#pragma unroll 4
        for (int i = 0; i < 16; ++i) { const f32x4 w = *(const f32x4*)(wp + (size_t)(4 * i) * (NMOD * DM)); const int k = kbase + 4 * i + rg;
            a0 += w * sl[k]; a1 += w * sl[DM + k]; a2 += w * sl[2 * DM + k]; }
#pragma unroll
        for (int j = 0; j < 4; ++j) { a0[j] += __shfl_xor(a0[j], 16); a0[j] += __shfl_xor(a0[j], 32); a1[j] += __shfl_xor(a1[j], 16); a1[j] += __shfl_xor(a1[j], 32); a2[j] += __shfl_xor(a2[j], 16); a2[j] += __shfl_xor(a2[j], 32); }
        if (rg == 0) { LAS float* rp = red + F.wave * 192 + cl; *(LAS f32x4*)rp = a0; *(LAS f32x4*)(rp + 64) = a1; *(LAS f32x4*)(rp + 128) = a2; }
        __syncthreads();
        if (F.tid < 192) { float s = 0.f;
#pragma unroll
            for (int w = 0; w < 8; ++w) s += red[w * 192 + F.tid];
            const int r = F.tid / 64, cc = F.tid % 64; MODP[((size_t)kq * 3 + r) * (NMOD * DM) + cb * 64 + cc] = s; }
        __syncthreads();
    }
    LAS float* scr = (LAS float*)(F.lds + 32768 + F.wave * 12288);
    const int gw = F.bid * NWAVES + F.wave, NGW = F.G * NWAVES;
    constexpr int I_IN = 32 * 58, I_POOL = 4 * 32, I_UQ = 8 * 48, I_UKV = 4 * 64, I_OUT = 32 * 64, I_UP = 32 * 352, I_DOWN = 88 * 64;
    constexpr int NITEMS = I_IN + I_POOL + I_UQ + I_UKV + I_OUT + I_UP + I_DOWN;
    bf16* WIN = (bf16*)(ws + WS_WIN); bf16* WPOOL = (bf16*)(ws + WS_WPOOL); bf16* WUQ = (bf16*)(ws + WS_WUQ); bf16* WUKV = (bf16*)(ws + WS_WUKV);
    bf16* WOUT = (bf16*)(ws + WS_WOUT); bf16* WUP = (bf16*)(ws + WS_WUP); bf16* WDOWN = (bf16*)(ws + WS_WDOWN);
    for (int it = gw; it < NITEMS; it += NGW) {
        int r = it;
        if (r < I_UP) { const int nb = r % 352, kb = r / 352, n0 = nb * 32; const int nn = n0 < DFF ? n0 : n0 - DFF; const int drow = (nn >> 7) * 256 + (nn & 127) + (n0 < DFF ? 0 : 128);
            p0_transpose_item(a.w_up, 2 * DFF, DM, WUP, kb * 64, n0, drow, nullptr, scr, F.lane); continue; } r -= I_UP;
        if (r < I_DOWN) { const int nb = r % 64, kb = r / 64; p0_transpose_item(a.w_down, DM, DFF, WDOWN, kb * 64, nb * 32, nb * 32, nullptr, scr, F.lane); continue; } r -= I_DOWN;
        if (r < I_OUT) { const int nb = r % 64, kb = r / 64; p0_transpose_item(a.w_out, DM, DM, WOUT, kb * 64, nb * 32, nb * 32, nullptr, scr, F.lane); continue; } r -= I_OUT;
        if (r < I_IN) { const int nb = r % 58, kb = r / 58; p0_transpose_item(a.w_in, INW, DM, WIN, kb * 64, nb * 32, nb * 32, nullptr, scr, F.lane); continue; } r -= I_IN;
        if (r < I_UQ) { const int nb = r % 48, kb = r / 48, n0 = nb * 32; const int drow = (n0 / DQK) * 256 + (n0 % DQK); p0_transpose_item(a.w_uq, NH * DQK, QLORA, WUQ, kb * 64, n0, drow, a.q_a_g, scr, F.lane); continue; } r -= I_UQ;
        if (r < I_UKV) { const int nb = r % 64, kb = r / 64; p0_transpose_item(a.w_ukv, NH * 256, KVLORA, WUKV, kb * 64, nb * 32, nb * 32, nullptr, scr, F.lane); continue; } r -= I_UKV;
        { const int g = r / 32, rr = r % 32, nb = rr % 8, kb = rr / 8; p0_transpose_item(a.w_pool + (size_t)g * 65536, 256, 256, WPOOL + (size_t)g * 65536, kb * 64, nb * 32, nb * 32, nullptr, scr, F.lane); }
    }
    const int gt = F.bid * (NWAVES * 64) + F.tid, NGT = F.G * NWAVES * 64;
    const v4u z4 = {0u, 0u, 0u, 0u};
    for (int i = gt; i < 49152 + 32768; i += NGT) {
        if (i < 49152) *(GAS v4u*)(WIN + (size_t)INW * DM + (size_t)i * 8) = z4;
        else { const int j = i - 49152, h = j / 4096, q = j % 4096; *(GAS v4u*)(WUQ + ((size_t)h * 256 + 192) * QLORA + (size_t)q * 8) = z4; }
    }
    float* TAB = (float*)(ws + WS_TAB);
    for (int i = gt; i < 1024; i += NGT) { const int pos = i >> 4, fi = i & 15; const float inv = powf(10000.0f, -(float)fi / 16.0f); float s, c; sincos_small((float)pos * inv, s, c); TAB[2 * i] = c; TAB[2 * i + 1] = s; }
    bf16* CKVN = (bf16*)(ws + WS_CKVN); float* KPW = (float*)(ws + WS_KPW); float* SSQK = (float*)(ws + WS_SSQK);
    for (int i = gw; i < LAT_B * PAST; i += NGW) { const int b = i / PAST, kr = NCTX + b * KVSEG + (i % PAST);
        const f32x4 v = *(const f32x4*)(a.cache_ckv + (size_t)i * KVLORA + F.lane * 4);
        v2u o; o.x = pk2(v[0], v[1]); o.y = pk2(v[2], v[3]); *(GAS v2u*)(CKVN + (size_t)kr * KVLORA + F.lane * 4) = o;
        const float kp = a.cache_kpe[(size_t)i * ROPED + F.lane]; KPW[(size_t)kr * ROPED + F.lane] = kp * a.k_norm_g[DNOPE + F.lane];
        const float ss = wave_sum(kp * kp); if (F.lane == 0) SSQK[kr] = ss; }
}

__device__ __forceinline__ void phase_norm(const Frame& F, const Args& a, int which) {
    unsigned char* ws = a.ws; const float* MODP = (const float*)(ws + WS_MODP); float* MOD = (float*)(ws + WS_MOD);
    LAS float* TA = (LAS float*)F.lds; LAS float* TS = TA + 3 * DM;
    const float* g = which ? a.norm2_g : a.norm1_g; const int csh = which ? 3 : 0, csc = which ? 4 : 1;
    for (int i = F.tid; i < 3 * DM; i += NWAVES * 64) { const int r = i / DM, c = i % DM; float sh, sc;
        if (which == 0) { const int i0 = r * (NMOD * DM) + csh * DM + c, i1 = r * (NMOD * DM) + csc * DM + c; sh = a.b_mod[csh * DM + c]; sc = a.b_mod[csc * DM + c];
#pragma unroll
            for (int q = 0; q < 4; ++q) { sh += MODP[(size_t)q * 3 * (NMOD * DM) + i0]; sc += MODP[(size_t)q * 3 * (NMOD * DM) + i1]; } }
        else { sh = MOD[r * (NMOD * DM) + csh * DM + c]; sc = MOD[r * (NMOD * DM) + csc * DM + c]; }
        TA[i] = g[c] * (1.0f + sc); TS[i] = sh; }
    if (which == 0) { const int gt = F.bid * (NWAVES * 64) + F.tid, NGT = F.G * NWAVES * 64;
        for (int i = gt; i < 3 * NMOD * DM; i += NGT) { float s = a.b_mod[i % (NMOD * DM)];
#pragma unroll
            for (int q = 0; q < 4; ++q) s += MODP[(size_t)q * 3 * (NMOD * DM) + i];
            MOD[i] = s; } }
    __syncthreads();
    bf16* H = (bf16*)(ws + WS_H); const int gw = F.bid * NWAVES + F.wave, NGW = F.G * NWAVES;
    for (int m = gw; m < NTOK; m += NGW) {
        const float* xrow = which ? a.out + (size_t)m * DM : (m < NCTX ? a.x_prompt + (size_t)m * DM : a.x_sample + (size_t)(m - NCTX) * DM);
        const int cond = m < NCTX ? 0 : 1 + ((m - NCTX) >> 11);
        const GAS f32x4* xr = (const GAS f32x4*)xrow + F.lane;
        f32x4 v[8]; float s = 0.f;
#pragma unroll
        for (int j = 0; j < 8; ++j) { v[j] = xr[64 * j]; s += (v[j][0] * v[j][0] + v[j][1] * v[j][1]) + (v[j][2] * v[j][2] + v[j][3] * v[j][3]); }
        const float rstd = 1.0f / sqrtf(wave_sum(s) * (1.0f / DM) + EPSN);
        GAS v2u* o8 = (GAS v2u*)(H + (size_t)m * DM) + F.lane;
#pragma unroll
        for (int j = 0; j < 8; ++j) { const int c = 256 * j + 4 * F.lane; const f32x4 ta = *(const LAS f32x4*)(TA + cond * DM + c), ts = *(const LAS f32x4*)(TS + cond * DM + c);
            const f32x4 h = v[j] * rstd * ta + ts; v2u w; w.x = pk2(h[0], h[1]); w.y = pk2(h[2], h[3]); o8[64 * j] = w; }
    }
}

template <int W> __device__ __forceinline__ void poolmix_item(const bf16* PV, bf16* MIX, const float* pool_scale, int g, int rp, int lane) {
    const int row = 2 * rp + (lane >> 5), col = g * 256 + (lane & 31) * 8;
    const int T = row < NCTX ? CTX_T : LAT_T, t = row < NCTX ? (row & (CTX_T - 1)) : ((row - NCTX) & (LAT_T - 1));
    const int lo = max(t - W / 2, 0), hi = min(t - W / 2 + W - 1, T - 1);
    v4u q[W];
#pragma unroll
    for (int j = 0; j < W; ++j) { const int tt = min(max(t - W / 2 + j, 0), T - 1); q[j] = *(const GAS v4u*)(PV + (size_t)(row - t + tt) * POOLW + col); }
    float acc[8] = {0.f, 0.f, 0.f, 0.f, 0.f, 0.f, 0.f, 0.f};
#pragma unroll
    for (int j = 0; j < W; ++j) { const int tt = t - W / 2 + j; const float mk = (tt >= 0 && tt < T) ? 1.0f : 0.0f;
        acc[0] += mk * bflo(q[j].x); acc[1] += mk * bfhi(q[j].x); acc[2] += mk * bflo(q[j].y); acc[3] += mk * bfhi(q[j].y); acc[4] += mk * bflo(q[j].z); acc[5] += mk * bfhi(q[j].z); acc[6] += mk * bflo(q[j].w); acc[7] += mk * bfhi(q[j].w); }
    const v4u qc = q[W / 2];
    const float ic = 1.0f / (float)(hi - lo + 1);
    const f32x4 s0 = *(const f32x4*)(pool_scale + col), s1 = *(const f32x4*)(pool_scale + col + 4);
    v4u o; o.x = pk2((acc[0] * ic - bflo(qc.x)) * s0[0], (acc[1] * ic - bfhi(qc.x)) * s0[1]); o.y = pk2((acc[2] * ic - bflo(qc.y)) * s0[2], (acc[3] * ic - bfhi(qc.y)) * s0[3]);
    o.z = pk2((acc[4] * ic - bflo(qc.z)) * s1[0], (acc[5] * ic - bfhi(qc.z)) * s1[1]); o.w = pk2((acc[6] * ic - bflo(qc.w)) * s1[2], (acc[7] * ic - bfhi(qc.w)) * s1[3]);
    *(GAS v4u*)(MIX + (size_t)row * DM + col) = o;
}
__device__ __forceinline__ void phase_poolmix(const Frame& F, const Args& a) {
    unsigned char* ws = a.ws; const bf16* PV = (const bf16*)(ws + WS_PV); bf16* MIX = (bf16*)(ws + WS_MIX);
    const int gw = F.bid * NWAVES + F.wave, NGW = F.G * NWAVES;
    for (int it = gw; it < (NTOK / 2) * 4; it += NGW) {
        const int g = it & 3, rp = it >> 2;
        if (g == 0) poolmix_item<2>(PV, MIX, a.pool_scale, g, rp, F.lane); else if (g == 1) poolmix_item<4>(PV, MIX, a.pool_scale, g, rp, F.lane);
        else if (g == 2) poolmix_item<8>(PV, MIX, a.pool_scale, g, rp, F.lane); else poolmix_item<16>(PV, MIX, a.pool_scale, g, rp, F.lane);
    }
}

__device__ __forceinline__ void phase_convgate(const Frame& F, const Args& a) {
    unsigned char* ws = a.ws; const bf16* UP = (const bf16*)(ws + WS_UP); bf16* Gb = (bf16*)(ws + WS_G);
    const int gw = F.bid * NWAVES + F.wave, NGW = F.G * NWAVES;
    for (int it = gw; it < (NTOK / 32) * 11; it += NGW) {
        const int strip = it % 11, blk = it / 11, c0 = strip * 512 + F.lane * 8, r0 = blk * 32;
        const int ua = (c0 >> 7) * 256 + (c0 & 127);
        const int T = r0 < NCTX ? CTX_T : LAT_T, t0 = r0 < NCTX ? (r0 & (CTX_T - 1)) : ((r0 - NCTX) & (LAT_T - 1));
        float wa[3][8], wb[3][8], ba[8], bb[8];
#pragma unroll
        for (int j = 0; j < 3; ++j)
#pragma unroll
            for (int e = 0; e < 8; ++e) { wa[j][e] = a.conv_w[(size_t)j * 2 * DFF + c0 + e]; wb[j][e] = a.conv_w[(size_t)j * 2 * DFF + DFF + c0 + e]; }
#pragma unroll
        for (int e = 0; e < 8; ++e) { ba[e] = a.conv_b[c0 + e]; bb[e] = a.conv_b[DFF + c0 + e]; }
        const v4u z4 = {0u, 0u, 0u, 0u};
        v4u pa = z4, pb = z4, ca, cb;
        if (t0 > 0) { pa = *(const GAS v4u*)(UP + (size_t)(r0 - 1) * (2 * DFF) + ua); pb = *(const GAS v4u*)(UP + (size_t)(r0 - 1) * (2 * DFF) + ua + 128); }
        ca = *(const GAS v4u*)(UP + (size_t)r0 * (2 * DFF) + ua); cb = *(const GAS v4u*)(UP + (size_t)r0 * (2 * DFF) + ua + 128);
        for (int i = 0; i < 32; ++i) {
            v4u na = z4, nb = z4;
            if (t0 + i + 1 < T) { na = *(const GAS v4u*)(UP + (size_t)(r0 + i + 1) * (2 * DFF) + ua); nb = *(const GAS v4u*)(UP + (size_t)(r0 + i + 1) * (2 * DFF) + ua + 128); }
            float g[8];
#define CG(e, PA, CA, NA, PB, CB, NB) { const float za = wa[0][e] * (PA) + wa[1][e] * (CA) + wa[2][e] * (NA) + ba[e]; const float zb = wb[0][e] * (PB) + wb[1][e] * (CB) + wb[2][e] * (NB) + bb[e]; g[e] = silu_f(za) * zb; }
            CG(0, bflo(pa.x), bflo(ca.x), bflo(na.x), bflo(pb.x), bflo(cb.x), bflo(nb.x)) CG(1, bfhi(pa.x), bfhi(ca.x), bfhi(na.x), bfhi(pb.x), bfhi(cb.x), bfhi(nb.x))
            CG(2, bflo(pa.y), bflo(ca.y), bflo(na.y), bflo(pb.y), bflo(cb.y), bflo(nb.y)) CG(3, bfhi(pa.y), bfhi(ca.y), bfhi(na.y), bfhi(pb.y), bfhi(cb.y), bfhi(nb.y))
            CG(4, bflo(pa.z), bflo(ca.z), bflo(na.z), bflo(pb.z), bflo(cb.z), bflo(nb.z)) CG(5, bfhi(pa.z), bfhi(ca.z), bfhi(na.z), bfhi(pb.z), bfhi(cb.z), bfhi(nb.z))
            CG(6, bflo(pa.w), bflo(ca.w), bflo(na.w), bflo(pb.w), bflo(cb.w), bflo(nb.w)) CG(7, bfhi(pa.w), bfhi(ca.w), bfhi(na.w), bfhi(pb.w), bfhi(cb.w), bfhi(nb.w))
#undef CG
            v4u o; o.x = pk2(g[0], g[1]); o.y = pk2(g[2], g[3]); o.z = pk2(g[4], g[5]); o.w = pk2(g[6], g[7]);
            *(GAS v4u*)(Gb + (size_t)(r0 + i) * DFF + c0) = o;
            pa = ca; pb = cb; ca = na; cb = nb;
        }
    }
}

__device__ __forceinline__ void phase_convfix(const Frame& F, const Args& a) {
    unsigned char* ws = a.ws; const float* EDGE = (const float*)(ws + WS_EDGE); bf16* Gb = (bf16*)(ws + WS_G);
    const int gw = F.bid * NWAVES + F.wave, NGW = F.G * NWAVES;
    for (int it = gw; it < 14 * 22; it += NGW) {
        const int bd = it / 22, c = (it % 22) * 256 + F.lane * 4, pm = 16 + (bd / 7) * 8 + (bd % 7);
        f32x4 z1[2], z2[2];
#pragma unroll
        for (int ab = 0; ab < 2; ++ab) {
            const f32x4 zl = *(const f32x4*)(EDGE + ((size_t)(pm * 4 + 1) * 2 + ab) * DFF + c), uf = *(const f32x4*)(EDGE + ((size_t)((pm + 1) * 4 + 2) * 2 + ab) * DFF + c);
            const f32x4 zf = *(const f32x4*)(EDGE + ((size_t)((pm + 1) * 4 + 0) * 2 + ab) * DFF + c), ul = *(const f32x4*)(EDGE + ((size_t)(pm * 4 + 3) * 2 + ab) * DFF + c);
            const f32x4 w0 = *(const f32x4*)(a.conv_w + ab * DFF + c), w2 = *(const f32x4*)(a.conv_w + (size_t)2 * (2 * DFF) + ab * DFF + c);
            z1[ab] = zl + w2 * uf; z2[ab] = zf + w0 * ul; }
        v2u o1, o2; float g1[4], g2[4];
#pragma unroll
        for (int j = 0; j < 4; ++j) { g1[j] = silu_f(z1[0][j]) * z1[1][j]; g2[j] = silu_f(z2[0][j]) * z2[1][j]; }
        o1.x = pk2(g1[0], g1[1]); o1.y = pk2(g1[2], g1[3]); o2.x = pk2(g2[0], g2[1]); o2.y = pk2(g2[2], g2[3]);
        const size_t r1 = (size_t)pm * 256 + 255;
        *(GAS v2u*)(Gb + r1 * DFF + c) = o1; *(GAS v2u*)(Gb + (r1 + 1) * DFF + c) = o2;
    }
}

__global__ void __launch_bounds__(NWAVES * 64, 2) mk_fwd(Args args) {
    extern __shared__ __attribute__((aligned(16))) unsigned char lds[];
    Frame F;
    F.lds = (LAS unsigned char*)lds; F.tid = threadIdx.x; F.lane = F.tid & 63; F.wave = __builtin_amdgcn_readfirstlane(F.tid >> 6); F.G = gridDim.x; F.bid = blockIdx.x;
    volatile LAS unsigned* MISC = (volatile LAS unsigned*)(F.lds + MISC_OFF);
    unsigned char* ws = args.ws;
    for (int u = F.tid; u < 64; u += NWAVES * 64) MISC[u] = 0u;
    __syncthreads();
    XcdBarrier bar; bar.bar = (unsigned*)(ws + WS_CTL) + CW_BAR; bar.x = 0; bar.st = nullptr;
    if (N_LAUNCHES == 1) bar = xcd_barrier_post((unsigned*)(ws + WS_CTL) + CW_BAR, MISC + 8);
    const int lo = args.ph_lo, hi = args.ph_hi;
#define IN(k) (lo <= (k) && (k) < hi)
#define REP(k) for (int rep_ = 0; rep_ < 1 + ((MK_DUP >> (k)) & 1); ++rep_)
#define MK_DUP_REP rep_
#define SEAM(k) do { if (IN(k) && IN((k) + 1)) xcd_barrier(bar); } while (0)
    LAS float* sx = (LAS float*)(F.lds + SX_OFF);
    bf16* WIN = (bf16*)(ws + WS_WIN); bf16* WPOOL = (bf16*)(ws + WS_WPOOL); bf16* WUQ = (bf16*)(ws + WS_WUQ); bf16* WUKV = (bf16*)(ws + WS_WUKV);
    bf16* WOUT = (bf16*)(ws + WS_WOUT); bf16* WUP = (bf16*)(ws + WS_WUP); bf16* WDOWN = (bf16*)(ws + WS_WDOWN);
    bf16* Hb = (bf16*)(ws + WS_H); bf16* Ub = (bf16*)(ws + WS_U); bf16* PVb = (bf16*)(ws + WS_PV); bf16* CQb = (bf16*)(ws + WS_CQ); bf16* CKVN = (bf16*)(ws + WS_CKVN);
    bf16* Qb = (bf16*)(ws + WS_Q); bf16* Kb = (bf16*)(ws + WS_K); bf16* Vb = (bf16*)(ws + WS_V); bf16* MIX = (bf16*)(ws + WS_MIX); bf16* UPb = (bf16*)(ws + WS_UP); bf16* Gb = (bf16*)(ws + WS_G);
    float* MOD = (float*)(ws + WS_MOD); float* TAB = (float*)(ws + WS_TAB); float* SSQQ = (float*)(ws + WS_SSQQ); float* SSQK = (float*)(ws + WS_SSQK); float* KPW = (float*)(ws + WS_KPW);

    if (IN(0)) REP(0) { phase0(F, args); } SEAM(0);
    if (IN(1)) REP(1) { phase_norm(F, args, 0); } SEAM(1);
    if (IN(2)) REP(2) {
        pg8::Gemm g{Hb, WIN}; pg8::StaticOrder S; S.init(NTOK, 2048, F.G, F.bid);
        epi::EpiIn E{Ub, CQb, CKVN, SSQQ, SSQK, KPW, args.out + (size_t)NTOK * DM, args.out + (size_t)NTOK * DM + (size_t)NCTX * KVLORA, args.kv_a_g, args.k_norm_g, TAB};
        pg8::gemm_phase<pg8::Geo<DM, DM, DM, 0>>(F.lds, sx, g, S, E);
    } SEAM(2);
    if (IN(3)) REP(3) {
        { pg8::Gemm g{Ub, WPOOL}; pg8::StaticOrder S; S.init(NTOK, 1024, F.G, (F.bid + 128) % F.G); epi::EpiBf16<POOLW> E{PVb}; pg8::gemm_phase<pg8::Geo<POOLW, 256, 256, 512>>(F.lds, sx, g, S, E); }
        { pg8::Gemm g{CQb, WUQ}; pg8::StaticOrder S; S.init(NTOK, 2048, F.G, F.bid); epi::EpiQ E{Qb, SSQQ, args.q_norm_g, TAB}; pg8::gemm_phase<pg8::Geo<QLORA, QLORA, QLORA, 0>>(F.lds, sx, g, S, E); }
        { pg8::Gemm g{CKVN, WUKV}; pg8::StaticOrder S; S.init(KVROWS, 2048, F.G, F.bid); epi::EpiKV E{Kb, Vb, SSQK, KPW, args.k_norm_g}; pg8::gemm_phase<pg8::Geo<KVLORA, KVLORA, KVLORA, 0>>(F.lds, sx, g, S, E); }
    } SEAM(3);
    if (IN(4)) REP(4) {
        phase_poolmix(F, args);
        unsigned* actl = (unsigned*)(ws + WS_CTL) + CW_ATT;
        for (int c = F.bid; c < 256; c += F.G) {
            const int x = c & 7, j = c >> 3, bh = 2 * x + (j >> 4), b = bh >> 3, h = bh & 7, qb = (j & 15) >> 1, half = j & 1, pair = (bh * 8 + qb);
            const size_t q0 = (size_t)NCTX + (size_t)b * LAT_T + (size_t)qb * 256, k0 = (size_t)NCTX + (size_t)b * KVSEG + (size_t)half * (KVSEG / 2);
            const att::Split sp{(float*)(ws + WS_APART), (float*)(ws + WS_ASTAT), actl + 64 * pair + (MK_DUP_REP) * 64 * 128, pair * 2 + half, half};
            att::attn_dense_body<true>(Qb + q0 * (NH * DQK) + h * DQK, Kb + k0 * (NH * DQK) + h * DQK, Vb + k0 * (NH * DVH) + h * DVH, MIX + q0 * DM + POOLW + h * DVH, KVSEG / 2, (char*)lds, sp);
            if ((j & 1) == 0) { const int idx = x * 16 + (j >> 1), cb = idx >> 3, ch = idx & 7; const size_t cq0 = (size_t)cb * CTX_T; const att::Split s0{nullptr, nullptr, nullptr, 0, 0};
                att::attn_dense_body<false>(Qb + cq0 * (NH * DQK) + ch * DQK, Kb + cq0 * (NH * DQK) + ch * DQK, Vb + cq0 * (NH * DVH) + ch * DVH, MIX + cq0 * DM + POOLW + ch * DVH, CTX_T, (char*)lds, s0); }
        }
    } SEAM(4);
    if (IN(5)) REP(5) {
        pg8::Gemm g{MIX, WOUT}; pg8::StaticOrder S; S.init(NTOK, DM, F.G, F.bid);
        epi::EpiGateRes E{args.x_prompt, args.x_sample, args.out, MOD + 2 * DM}; pg8::gemm_phase<pg8::Geo<DM, DM, DM, 0>>(F.lds, sx, g, S, E);
    } SEAM(5);
    if (IN(6)) REP(6) { phase_norm(F, args, 1); } SEAM(6);
    if (IN(7)) REP(7) {
        pg8::Gemm g{Hb, WUP}; pg8::StaticOrder S; S.init(NTOK, 2 * DFF, F.G, F.bid); epi::EpiUpConv E{Gb, (float*)(ws + WS_EDGE), args.conv_w, args.conv_b}; pg8::gemm_phase<pg8::Geo<DM, DM, DM, 0>>(F.lds, sx, g, S, E);
    } SEAM(7);
    if (IN(8)) REP(8) { phase_convfix(F, args); } SEAM(8);
#if defined(MK_PROBE9)
    if (IN(9)) { pg8::Gemm g{Gb, WDOWN}; pg8::StaticOrder S; S.init(NTOK, DM, F.G, F.bid);
        epi::EpiGateRes E{args.out, args.out + (size_t)NCTX * DM, (float*)(ws + WS_UP), MOD + 5 * DM}; pg8::gemm_phase<pg8::Geo<DFF, DFF, DFF, 0>>(F.lds, sx, g, S, E); }
#endif
#if defined(MK_PROBEBAR)
    if (IN(9)) { for (int i = 0; i < 10; ++i) xcd_barrier(bar); }
#endif
    if (IN(9)) REP(9) {
        pg8::Gemm g{Gb, WDOWN}; pg8::StaticOrder S; S.init(NTOK, DM, F.G, F.bid);
        epi::EpiGateRes E{args.out, args.out + (size_t)NCTX * DM, args.out, MOD + 5 * DM}; pg8::gemm_phase<pg8::Geo<DFF, DFF, DFF, 0>>(F.lds, sx, g, S, E);
    }
#undef IN
#undef SEAM
}

extern "C" void kernel_launch(void* const* d_in, const int* in_sizes, int n_in, void* d_out, int out_size, void* d_ws, size_t ws_size, hipStream_t stream) {
    static int grid = 0;
    if (grid == 0) {
        if (n_in != 24 || in_sizes[0] != NCTX * DM || in_sizes[8] != DM * NMOD * DM || ws_size < WS_END) {
            fprintf(stderr, "kernel_launch: unexpected shapes: n_in %d in0 %d in8 %d ws %zu (need >= %zu); nothing launched\n", n_in, n_in > 0 ? in_sizes[0] : -1, n_in > 8 ? in_sizes[8] : -1, ws_size, (size_t)WS_END); grid = -1; return; }
        int dev = 0, cus = 0;
        if (hipGetDevice(&dev) != hipSuccess || hipDeviceGetAttribute(&cus, hipDeviceAttributeMultiprocessorCount, dev) != hipSuccess) { fprintf(stderr, "kernel_launch: device query failed\n"); grid = -1; return; }
        if (hipFuncSetAttribute((const void*)mk_fwd, hipFuncAttributeMaxDynamicSharedMemorySize, LDS_BYTES) != hipSuccess) { fprintf(stderr, "kernel_launch: hipFuncSetAttribute failed\n"); grid = -1; return; }
        (void)hipGetLastError();
        grid = cus;
    }
    if (grid < 0) return;
    if (hipMemsetAsync((char*)d_ws + WS_CTL, 0, CTL_ZERO_BYTES, stream) != hipSuccess) { fprintf(stderr, "kernel_launch: memset failed\n"); return; }
    Args a{};
    const float** ap = (const float**)&a;
    for (int i = 0; i < 24; ++i) ap[i] = (const float*)d_in[i];
    a.out = (float*)d_out; a.ws = (unsigned char*)d_ws;
    for (int li = 0; li < N_LAUNCHES; ++li) {
        a.ph_lo = (N_LAUNCHES == 1) ? 0 : li; a.ph_hi = (N_LAUNCHES == 1) ? N_PHASES : li + 1; a.li = li;
        hipLaunchKernelGGL(mk_fwd, dim3(grid), dim3(NWAVES * 64), LDS_BYTES, stream, a);
        const hipError_t le = hipPeekAtLastError();
        if (le != hipSuccess) { fprintf(stderr, "kernel_launch: launch %d failed: %s\n", li, hipGetErrorName(le)); break; }
    }
}
```

```cpp
#include <hip/hip_runtime.h>
#include <cstdio>
#include <cstdint>
namespace pg8 {
#define PG8_LAS __attribute__((address_space(3)))
typedef unsigned short bf16_t;
typedef short bf16x8 __attribute__((ext_vector_type(8)));
typedef float f32x4 __attribute__((ext_vector_type(4)));
typedef float f32x2 __attribute__((ext_vector_type(2)));
typedef unsigned u32x4 __attribute__((ext_vector_type(4)));
typedef unsigned u32x2 __attribute__((ext_vector_type(2)));
constexpr int BM = 256, BK = 64, HALF = 128, HTB = HALF * BK * 2  , STAGE_BYTES = 8 * HTB, NXCD = 8, WGM = 8;

__host__ __device__ __forceinline__ int lds_byte(int r, int c) { const int st = (r >> 4) * 2 + (c >> 5), rr = r & 15, cc = c & 31, ob = rr * 64 + cc * 2; return st * 1024 + (ob ^ (((ob >> 9) & 1) << 5)); }
__host__ __device__ __forceinline__ void stage_rc(int b, int& R, int& C) { const int st = b / 1024, sb = b % 1024, swz = sb ^ (((sb >> 9) & 1) << 5); R = (st >> 1) * 16 + swz / 64; C = (st & 1) * 32 + (swz % 64) / 2; }
__host__ __device__ __forceinline__ int perm32(int rho) { const int n = rho >> 4, i = rho & 15; return 8 * (i >> 2) + 4 * n + (i & 3); }

struct Unit { int pm, pn; };
struct Gemm { const bf16_t* A; const bf16_t* Bt; };
template <int LDA, int LDB, int KK, int APN> struct Geo { static constexpr int lda = LDA, ldb = LDB, K = KK, a_pn_bytes = APN; };

struct StaticOrder {
    int nM, nN, nwg, G, c;
    __host__ __device__ void init(int M, int N, int G_, int c_) { nM = M / BM; nN = N / BM; nwg = nM * nN; G = G_; c = c_; }
    __host__ __device__ bool next(int i, Unit& u) const {
        const long L = (long)i * G + c; if (L >= nwg) return false;
        int wgid = (int)L; { const int q = nwg / NXCD, r = nwg % NXCD, xcd = wgid % NXCD, off = wgid / NXCD; wgid = (xcd < r ? xcd * (q + 1) : r * (q + 1) + (xcd - r) * q) + off; }
        const int nig = WGM * nN, gid = wgid / nig, fm = gid * WGM, gsz = (nM - fm) < WGM ? (nM - fm) : WGM;
        u.pm = fm + ((wgid % nig) % gsz); u.pn = (wgid % nig) / gsz; return true;
    }
};

__device__ __forceinline__ unsigned cvt_pk_bf16(float lo, float hi) { unsigned r; asm volatile("v_cvt_pk_bf16_f32 %0, %1, %2" : "=v"(r) : "v"(lo), "v"(hi)); return r; }


template <class GEO, class Epi, class Sched>
__device__ __forceinline__ void gemm_phase(PG8_LAS unsigned char* lds, PG8_LAS float* sx, const Gemm g, const Sched& S, const Epi& E) {
    int tid_ = threadIdx.x; asm volatile("" : "+v"(tid_));
    const int tid = tid_, wid = __builtin_amdgcn_readfirstlane(tid >> 6), lane = tid & 63, wr = wid >> 2, wc = wid & 3, fr = lane & 15, fq = lane >> 4;
    constexpr int K = GEO::K, nt = K / BK;
    unsigned voffA[2], voffB[2];
#pragma unroll
    for (int i = 0; i < 2; ++i) { int R, C; stage_rc(tid * 16 + i * 8192, R, C); const int Rb = Epi::PERM ? ((R & ~31) + perm32(R & 31)) : R;
        voffA[i] = (unsigned)(R * GEO::lda + C) * 2u; voffB[i] = (unsigned)(Rb * GEO::ldb + C) * 2u; }
    const size_t kstep = (size_t)(BK * 2);
    const size_t hstepA = (size_t)HALF * GEO::lda * 2, hstepB = (size_t)HALF * GEO::ldb * 2;
    const size_t tstepA = 2 * hstepA, tstepB = 2 * hstepB;
    const unsigned ldsw = (unsigned)wid * 1024u;
    const int aoff = lds_byte(wr * 64 + fr, fq * 8), boff = lds_byte(wc * 32 + fr, fq * 8);
#define PG8_SA(b, h) (((b) * 2 + (h)) * HTB)
#define PG8_SB(b, h) ((4 + (b) * 2 + (h)) * HTB)
#define PG8_STAGE(bufoff, gbase, voff) do { _Pragma("unroll") for (int _i = 0; _i < 2; ++_i) \
        __builtin_amdgcn_global_load_lds((const unsigned*)((const char*)(gbase) + (voff)[_i]), (PG8_LAS unsigned*)(lds + (bufoff) + ldsw + _i * 8192), 16, 0, 0); } while (0)
#define PG8_LDA(dst, b, h) do { _Pragma("unroll") for (int m = 0; m < 4; ++m) _Pragma("unroll") for (int k = 0; k < 2; ++k) dst[m][k] = *(const PG8_LAS bf16x8*)(lds + PG8_SA(b, h) + aoff + m * 2048 + k * 1024); } while (0)
#define PG8_LDB(dst, b, h) do { _Pragma("unroll") for (int n = 0; n < 2; ++n) _Pragma("unroll") for (int k = 0; k < 2; ++k) dst[n][k] = *(const PG8_LAS bf16x8*)(lds + PG8_SB(b, h) + boff + n * 2048 + k * 1024); } while (0)
#define PG8_MMA(ai, bj, At, Bt) do { __builtin_amdgcn_s_setprio(1); _Pragma("unroll") for (int m = 0; m < 4; ++m) _Pragma("unroll") for (int n = 0; n < 2; ++n) _Pragma("unroll") for (int k = 0; k < 2; ++k) \
        acc[ai][bj][m][n] = __builtin_amdgcn_mfma_f32_16x16x32_bf16(Bt[n][k], At[m][k], acc[ai][bj][m][n], 0, 0, 0); __builtin_amdgcn_s_setprio(0); } while (0)
#define PG8_WAIT_V(n) asm volatile("s_waitcnt vmcnt(" #n ")" ::: "memory")
#define PG8_WAIT_L(n) asm volatile("s_waitcnt lgkmcnt(" #n ")" ::: "memory")
#define PG8_BAR __builtin_amdgcn_s_barrier()
#define PG8_SCHED __builtin_amdgcn_sched_barrier(0)
    Unit cur, nxt; int ui = 0;
    if (!S.next(0, cur)) return;
    f32x4 acc[2][2][4][2];
#pragma unroll
    for (int a = 0; a < 2; ++a)
#pragma unroll
        for (int b = 0; b < 2; ++b)
#pragma unroll
            for (int m = 0; m < 4; ++m)
#pragma unroll
                for (int n = 0; n < 2; ++n) acc[a][b][m][n] = (f32x4){0.f, 0.f, 0.f, 0.f};
    bf16x8 At[4][2], B0[2][2], B1[2][2];
    const char* cA = (const char*)g.A + (size_t)cur.pm * tstepA + (size_t)cur.pn * GEO::a_pn_bytes; const char* cB = (const char*)g.Bt + (size_t)cur.pn * tstepB;
    PG8_STAGE(PG8_SB(0, 0), cB, voffB); PG8_STAGE(PG8_SB(0, 1), cB + hstepB, voffB); PG8_STAGE(PG8_SA(0, 0), cA, voffA); PG8_STAGE(PG8_SA(0, 1), cA + hstepA, voffA);
    if (wr == 1) PG8_BAR;
    PG8_WAIT_V(2); PG8_BAR;
    PG8_STAGE(PG8_SB(1, 0), cB + kstep, voffB); PG8_STAGE(PG8_SA(1, 0), cA + kstep, voffA); PG8_STAGE(PG8_SB(1, 1), cB + hstepB + kstep, voffB);
    PG8_WAIT_V(6); PG8_BAR;
    for (;;) {
        const bool has_next = S.next(ui + 1, nxt);
        const char* nA = has_next ? (const char*)g.A + (size_t)nxt.pm * tstepA + (size_t)nxt.pn * GEO::a_pn_bytes : cA; const char* nB = has_next ? (const char*)g.Bt + (size_t)nxt.pn * tstepB : cB;
#pragma unroll 1
        for (int t = 0; t < nt; t += 2) {
            const bool last = (t == nt - 2);
            const char* a1 = cA + (size_t)(t + 1) * kstep;
            const char* a2 = last ? nA : cA + (size_t)(t + 2) * kstep; const char* b2 = last ? nB : cB + (size_t)(t + 2) * kstep;
            const char* a3 = a2 + kstep; const char* b3 = b2 + kstep;
            PG8_LDB(B0, 0, 0); PG8_LDB(B1, 0, 1); PG8_SCHED; PG8_LDA(At, 0, 0); PG8_STAGE(PG8_SA(1, 1), a1 + hstepA, voffA);
            PG8_WAIT_V(8); PG8_WAIT_L(0); PG8_BAR; PG8_MMA(0, 0, At, B0); PG8_MMA(0, 1, At, B1); PG8_BAR; PG8_SCHED;
            PG8_LDA(At, 0, 1); PG8_STAGE(PG8_SB(0, 0), b2, voffB); PG8_STAGE(PG8_SB(0, 1), b2 + hstepB, voffB); PG8_STAGE(PG8_SA(0, 0), a2, voffA);
            PG8_WAIT_V(8); PG8_WAIT_L(0); PG8_BAR; PG8_MMA(1, 0, At, B0); PG8_MMA(1, 1, At, B1); PG8_BAR; PG8_SCHED;
            PG8_LDB(B0, 1, 0); PG8_LDB(B1, 1, 1); PG8_SCHED; PG8_LDA(At, 1, 0); PG8_STAGE(PG8_SA(0, 1), a2 + hstepA, voffA);
            PG8_WAIT_V(8); PG8_WAIT_L(0); PG8_BAR; PG8_MMA(0, 0, At, B0); PG8_MMA(0, 1, At, B1); PG8_BAR; PG8_SCHED;
            PG8_LDA(At, 1, 1); PG8_STAGE(PG8_SB(1, 0), b3, voffB); PG8_STAGE(PG8_SB(1, 1), b3 + hstepB, voffB); PG8_STAGE(PG8_SA(1, 0), a3, voffA);
            PG8_WAIT_V(8); PG8_WAIT_L(0); PG8_BAR; PG8_MMA(1, 0, At, B0); PG8_MMA(1, 1, At, B1); PG8_BAR; PG8_SCHED;
        }
        if (wr == 0) PG8_BAR;
        { int fr_ = fr, fq_ = fq; asm volatile("" : "+v"(fr_), "+v"(fq_));
          E(acc, cur, wr, wc, fr_, fq_, sx); }
        if (!has_next) break;
#pragma unroll
        for (int a = 0; a < 2; ++a)
#pragma unroll
            for (int b = 0; b < 2; ++b)
#pragma unroll
                for (int m = 0; m < 4; ++m)
#pragma unroll
                    for (int n = 0; n < 2; ++n) acc[a][b][m][n] = (f32x4){0.f, 0.f, 0.f, 0.f};
        cur = nxt; cA = nA; cB = nB; ++ui;
        if (wr == 1) PG8_BAR;
    }
    PG8_WAIT_V(0);
    PG8_BAR;
#undef PG8_SA
#undef PG8_SB
#undef PG8_STAGE
#undef PG8_LDA
#undef PG8_LDB
#undef PG8_MMA
}
}
constexpr int DM = 2048, NTOK = 8192, NCTX = 4096, LAT_T = 2048, LAT_B = 2, CTX_T = 256, PAST = 512;
constexpr int KVSEG = PAST + LAT_T;
constexpr int KVROWS = NCTX + LAT_B * KVSEG;
constexpr int POOLW = 1024, QLORA = 512, KVLORA = 256, ROPED = 64, INW = 1856, NH = 8, DQK = 192, DNOPE = 128, DVH = 128, DFF = 5632, NMOD = 6;
constexpr float EPSN = 1e-6f;

__device__ __forceinline__ int kvrow_of(int row) { return row < NCTX ? row : NCTX + ((row - NCTX) >> 11) * KVSEG + PAST + ((row - NCTX) & (LAT_T - 1)); }

namespace epi {
using namespace pg8;
#define EPI_LAS __attribute__((address_space(3)))
__device__ __forceinline__ float fq_sum(float s) { s += __shfl_xor(s, 16); s += __shfl_xor(s, 32); return s; }
__device__ __forceinline__ void lds_bar() { asm volatile("s_waitcnt lgkmcnt(0)" ::: "memory"); __builtin_amdgcn_s_barrier(); asm volatile("" ::: "memory"); }
__device__ __forceinline__ u32x4 pack8(const f32x4 a, const f32x4 b) { u32x4 w; w.x = cvt_pk_bf16(a[0], a[1]); w.y = cvt_pk_bf16(a[2], a[3]); w.z = cvt_pk_bf16(b[0], b[1]); w.w = cvt_pk_bf16(b[2], b[3]); return w; }
__device__ __forceinline__ float sq4(const f32x4 v) { return (v[0] * v[0] + v[1] * v[1]) + (v[2] * v[2] + v[3] * v[3]); }

template <int ldc> struct EpiBf16 {
    static constexpr bool PERM = true;
    bf16_t* O;
    __device__ __forceinline__ void operator()(const f32x4 (&acc)[2][2][4][2], const Unit& u, int wr, int wc, int fr, int fq, EPI_LAS float*) const {
        const int row0 = u.pm * BM + wr * 64 + fr, col0 = u.pn * BM + wc * 32 + 8 * fq;
#pragma unroll
        for (int ai = 0; ai < 2; ++ai)
#pragma unroll
            for (int m = 0; m < 4; ++m) { bf16_t* rowp = O + (size_t)(row0 + ai * HALF + m * 16) * ldc + col0;
#pragma unroll
                for (int bj = 0; bj < 2; ++bj) *(u32x4*)(rowp + bj * HALF) = pack8(acc[ai][bj][m][0], acc[ai][bj][m][1]); }
    }
};

__device__ __forceinline__ f32x4 rope4(const f32x4 w, const float* tab, int pos, int fq, int n) {
    f32x4 p; p[0] = __shfl_xor(w[0], 32); p[1] = __shfl_xor(w[1], 32); p[2] = __shfl_xor(w[2], 32); p[3] = __shfl_xor(w[3], 32);
    const float* tp = tab + ((size_t)pos * 16 + 8 * (fq & 1) + 4 * n) * 2;
    const f32x4 c0 = *(const f32x4*)tp, c1 = *(const f32x4*)(tp + 4);
    const float sg = (fq < 2) ? -1.f : 1.f;
    f32x4 o; o[0] = w[0] * c0[0] + sg * p[0] * c0[1]; o[1] = w[1] * c0[2] + sg * p[1] * c0[3]; o[2] = w[2] * c1[0] + sg * p[2] * c1[1]; o[3] = w[3] * c1[2] + sg * p[3] * c1[3];
    return o;
}

struct EpiIn {
    static constexpr bool PERM = true;
    bf16_t* U; bf16_t* CQ; bf16_t* CKVN; float* SSQQ; float* SSQK; float* KPW; float* out_ckv; float* out_kpe;
    const float* kv_a_g; const float* k_norm_g; const float* tab;
    __device__ __forceinline__ void operator()(const f32x4 (&acc)[2][2][4][2], const Unit& u, int wr, int wc, int fr, int fq, EPI_LAS float* part) const {
        const int pn = u.pn, rl0 = wr * 64 + fr, row0 = u.pm * BM + rl0, cl0 = wc * 32 + 8 * fq;
        if (pn < 4) {
#pragma unroll
            for (int ai = 0; ai < 2; ++ai)
#pragma unroll
                for (int m = 0; m < 4; ++m) { bf16_t* rowp = U + (size_t)(row0 + ai * HALF + m * 16) * POOLW + pn * BM + cl0;
#pragma unroll
                    for (int bj = 0; bj < 2; ++bj) *(u32x4*)(rowp + bj * HALF) = pack8(acc[ai][bj][m][0], acc[ai][bj][m][1]); }
            return;
        }
        const bool kpe_tile = (pn == 7);
#pragma unroll
        for (int ai = 0; ai < 2; ++ai)
#pragma unroll
            for (int m = 0; m < 4; ++m) {
                float s = sq4(acc[ai][0][m][0]) + sq4(acc[ai][0][m][1]);
                if (kpe_tile) { if (wc >= 2) s = 0.f; } else s += sq4(acc[ai][1][m][0]) + sq4(acc[ai][1][m][1]);
                s = fq_sum(s);
                if (fq == 0) part[(ai * HALF + rl0 + m * 16) * 4 + wc] = s;
            }
        lds_bar();
        if (pn < 6) {
#pragma unroll
            for (int ai = 0; ai < 2; ++ai)
#pragma unroll
                for (int m = 0; m < 4; ++m) { const int rl = ai * HALF + rl0 + m * 16, row = u.pm * BM + rl;
                    bf16_t* rowp = CQ + (size_t)row * QLORA + (pn - 4) * BM + cl0;
#pragma unroll
                    for (int bj = 0; bj < 2; ++bj) *(u32x4*)(rowp + bj * HALF) = pack8(acc[ai][bj][m][0], acc[ai][bj][m][1]);
                    if (wc == 0 && fq == 0) { const f32x4 p4 = *(const EPI_LAS f32x4*)(part + rl * 4); SSQQ[(pn - 4) * NTOK + row] = (p4[0] + p4[1]) + (p4[2] + p4[3]); } }
        } else if (pn == 6) {
            f32x4 gv[2][2];
#pragma unroll
            for (int bj = 0; bj < 2; ++bj)
#pragma unroll
                for (int n = 0; n < 2; ++n) gv[bj][n] = *(const f32x4*)(kv_a_g + bj * HALF + cl0 + 4 * n);
#pragma unroll
            for (int ai = 0; ai < 2; ++ai)
#pragma unroll
                for (int m = 0; m < 4; ++m) { const int rl = ai * HALF + rl0 + m * 16, row = u.pm * BM + rl;
                    const f32x4 p4 = *(const EPI_LAS f32x4*)(part + rl * 4); const float rstd = 1.0f / sqrtf(((p4[0] + p4[1]) + (p4[2] + p4[3])) * (1.0f / KVLORA) + EPSN);
                    bf16_t* rowp = CKVN + (size_t)kvrow_of(row) * KVLORA + cl0;
#pragma unroll
                    for (int bj = 0; bj < 2; ++bj) { const f32x4 v0 = acc[ai][bj][m][0] * rstd * gv[bj][0], v1 = acc[ai][bj][m][1] * rstd * gv[bj][1];
                        *(u32x4*)(rowp + bj * HALF) = pack8(v0, v1);
                        if (row < NCTX) { float* op = out_ckv + (size_t)row * KVLORA + bj * HALF + cl0; *(f32x4*)op = v0; *(f32x4*)(op + 4) = v1; } } }
        } else {
            const bool lat = (u.pm >= NCTX / BM);
            if (wc < 2) {
                f32x4 gv[2];
#pragma unroll
                for (int n = 0; n < 2; ++n) gv[n] = *(const f32x4*)(k_norm_g + DNOPE + cl0 + 4 * n);
#pragma unroll
                for (int ai = 0; ai < 2; ++ai)
#pragma unroll
                    for (int m = 0; m < 4; ++m) { const int rl = ai * HALF + rl0 + m * 16, row = u.pm * BM + rl, kr = kvrow_of(row);
#pragma unroll
                        for (int n = 0; n < 2; ++n) { f32x4 w = acc[ai][0][m][n] * gv[n];
                            if (lat) { const int t = (row - NCTX) & (LAT_T - 1); w = rope4(w, tab, wc == 0 ? (t >> 6) : (t & 63), fq, n); }
                            else *(f32x4*)(out_kpe + (size_t)row * ROPED + cl0 + 4 * n) = acc[ai][0][m][n];
                            *(f32x4*)(KPW + (size_t)kr * ROPED + cl0 + 4 * n) = w; }
                        if (wc == 0 && fq == 0) { const f32x4 p4 = *(const EPI_LAS f32x4*)(part + rl * 4); SSQK[kr] = (p4[0] + p4[1]) + (p4[2] + p4[3]); } }
            }
        }
    }
};

struct EpiQ {
    static constexpr bool PERM = true;
    bf16_t* Q; const float* SSQQ; const float* q_norm_g; const float* tab;
    __device__ __forceinline__ void operator()(f32x4 (&acc)[2][2][4][2], const Unit& u, int wr, int wc, int fr, int fq, EPI_LAS float* part) const {
        const int h = u.pn, rl0 = wr * 64 + fr, cl0 = wc * 32 + 8 * fq; const bool lat = (u.pm >= NCTX / BM), v1ok = (wc < 2);
#pragma unroll
        for (int ai = 0; ai < 2; ++ai)
#pragma unroll
            for (int m = 0; m < 4; ++m) { const int rl = ai * HALF + rl0 + m * 16, row = u.pm * BM + rl;
                const float rc = 1.0f / sqrtf((SSQQ[row] + SSQQ[NTOK + row]) * (1.0f / QLORA) + EPSN);
#pragma unroll
                for (int bj = 0; bj < 2; ++bj)
#pragma unroll
                    for (int n = 0; n < 2; ++n) acc[ai][bj][m][n] = acc[ai][bj][m][n] * rc;
                float s = sq4(acc[ai][0][m][0]) + sq4(acc[ai][0][m][1]);
                if (v1ok) s += sq4(acc[ai][1][m][0]) + sq4(acc[ai][1][m][1]);
                s = fq_sum(s);
                if (fq == 0) part[rl * 4 + wc] = s;
            }
        lds_bar();
        f32x4 gv[2][2];
#pragma unroll
        for (int bj = 0; bj < 2; ++bj)
#pragma unroll
            for (int n = 0; n < 2; ++n) gv[bj][n] = (bj == 0 || v1ok) ? *(const f32x4*)(q_norm_g + bj * HALF + cl0 + 4 * n) : (f32x4){0.f, 0.f, 0.f, 0.f};
#pragma unroll
        for (int ai = 0; ai < 2; ++ai)
#pragma unroll
            for (int m = 0; m < 4; ++m) { const int rl = ai * HALF + rl0 + m * 16, row = u.pm * BM + rl;
                const f32x4 p4 = *(const EPI_LAS f32x4*)(part + rl * 4); const float rn = 1.0f / sqrtf(((p4[0] + p4[1]) + (p4[2] + p4[3])) * (1.0f / DQK) + EPSN);
                bf16_t* rowp = Q + (size_t)row * (NH * DQK) + h * DQK + cl0;
                *(u32x4*)rowp = pack8(acc[ai][0][m][0] * rn * gv[0][0], acc[ai][0][m][1] * rn * gv[0][1]);
                if (v1ok) { f32x4 w0 = acc[ai][1][m][0] * rn * gv[1][0], w1 = acc[ai][1][m][1] * rn * gv[1][1];
                    if (lat) { const int t = (row - NCTX) & (LAT_T - 1), pos = (wc == 0) ? (t >> 6) : (t & 63); w0 = rope4(w0, tab, pos, fq, 0); w1 = rope4(w1, tab, pos, fq, 1); }
                    *(u32x4*)(rowp + HALF) = pack8(w0, w1); } }
    }
};

#define EPI_PIN(x) asm volatile("" : "+v"(x))
#define EPI_FENCE() asm volatile("" ::: "memory")
struct EpiKV {
    static constexpr bool PERM = true;
    bf16_t* Kb; bf16_t* Vb; const float* SSQK; const float* KPW; const float* k_norm_g;
    __device__ __forceinline__ void operator()(const f32x4 (&acc)[2][2][4][2], const Unit& u, int wr, int wc, int fr, int fq, EPI_LAS float* part) const {
        const int h = u.pn, rl0 = wr * 64 + fr, cl0 = wc * 32 + 8 * fq, e = 16 * wc + 4 * fq;
        float sk[4]; f32x4 kw[4];
        int kr0 = u.pm * BM + rl0; EPI_PIN(kr0);
#pragma unroll
        for (int m = 0; m < 4; ++m) { const int kr = kr0 + m * 16; sk[m] = SSQK[kr]; kw[m] = *(const f32x4*)(KPW + (size_t)kr * ROPED + e); }
#pragma unroll
        for (int ai = 0; ai < 2; ++ai)
#pragma unroll
            for (int m = 0; m < 4; ++m) { float s = sq4(acc[ai][0][m][0]) + sq4(acc[ai][0][m][1]); s = fq_sum(s); if (fq == 0) part[(ai * HALF + rl0 + m * 16) * 4 + wc] = s; }
        lds_bar();
        f32x4 gv[2];
#pragma unroll
        for (int n = 0; n < 2; ++n) gv[n] = *(const f32x4*)(k_norm_g + cl0 + 4 * n);
#pragma unroll
        for (int ai = 0; ai < 2; ++ai) {
            if (ai == 1) { int kr1 = u.pm * BM + HALF + rl0; EPI_PIN(kr1);
#pragma unroll
                for (int m = 0; m < 4; ++m) { const int kr = kr1 + m * 16; sk[m] = SSQK[kr]; kw[m] = *(const f32x4*)(KPW + (size_t)kr * ROPED + e); } }
#pragma unroll
            for (int m = 0; m < 4; ++m) { const int rl = ai * HALF + rl0 + m * 16; int kr = u.pm * BM + rl; EPI_PIN(kr);
                const f32x4 p4 = *(const EPI_LAS f32x4*)(part + rl * 4); const float rk = 1.0f / sqrtf((((p4[0] + p4[1]) + (p4[2] + p4[3])) + sk[m]) * (1.0f / DQK) + EPSN);
                bf16_t* kp = Kb + (size_t)kr * (NH * DQK) + h * DQK;
                *(u32x4*)(kp + cl0) = pack8(acc[ai][0][m][0] * rk * gv[0], acc[ai][0][m][1] * rk * gv[1]);
                *(u32x4*)(Vb + (size_t)kr * (NH * DVH) + h * DVH + cl0) = pack8(acc[ai][1][m][0], acc[ai][1][m][1]);
                const f32x4 kv = kw[m] * rk;
                u32x2 w; w.x = cvt_pk_bf16(kv[0], kv[1]); w.y = cvt_pk_bf16(kv[2], kv[3]); *(u32x2*)(kp + DNOPE + e) = w;
                EPI_FENCE(); }
        }
    }
};

template <int CTRL> __device__ __forceinline__ float dpp_upd(float old, float src) {
    return __builtin_bit_cast(float, __builtin_amdgcn_update_dpp(__builtin_bit_cast(int, old), __builtin_bit_cast(int, src), CTRL, 0xf, 0xf, false)); }
struct EpiUpConv {
    static constexpr bool PERM = true;
    bf16_t* G; float* EDGE; const float* conv_w; const float* conv_b;
    __device__ __forceinline__ void operator()(const f32x4 (&acc)[2][2][4][2], const Unit& u, int wr, int wc, int fr, int fq, EPI_LAS float* E) const {
        const int cl0 = wc * 32 + 8 * fq;
#pragma unroll
        for (int ai = 0; ai < 2; ++ai) { const int rb = 2 * ai + wr;
            if (fr == 0) {
#pragma unroll
                for (int ab = 0; ab < 2; ++ab)
#pragma unroll
                    for (int n = 0; n < 2; ++n) *(EPI_LAS f32x4*)(E + ((rb * 2 + 0) * 2 + ab) * 128 + cl0 + 4 * n) = acc[ai][ab][0][n]; }
            if (fr == 15) {
#pragma unroll
                for (int ab = 0; ab < 2; ++ab)
#pragma unroll
                    for (int n = 0; n < 2; ++n) *(EPI_LAS f32x4*)(E + ((rb * 2 + 1) * 2 + ab) * 128 + cl0 + 4 * n) = acc[ai][ab][3][n]; } }
        lds_bar();
        const bool lat = (u.pm >= NCTX / BM);
#pragma unroll
        for (int n = 0; n < 2; ++n) {
            int c = u.pn * HALF + cl0 + 4 * n; EPI_PIN(c);
            f32x4 w[2][3], bs[2];
#pragma unroll
            for (int ab = 0; ab < 2; ++ab) { bs[ab] = *(const f32x4*)(conv_b + ab * DFF + c);
#pragma unroll
                for (int k = 0; k < 3; ++k) w[ab][k] = *(const f32x4*)(conv_w + (size_t)k * (2 * DFF) + ab * DFF + c); }
#pragma unroll
            for (int ai = 0; ai < 2; ++ai) { const int rb = 2 * ai + wr;
                f32x4 z[2][4];
#pragma unroll
                for (int ab = 0; ab < 2; ++ab) {
                    f32x4 pe = {0.f, 0.f, 0.f, 0.f}, ne = pe;
                    if (rb > 0) pe = *(const EPI_LAS f32x4*)(E + (((rb - 1) * 2 + 1) * 2 + ab) * 128 + cl0 + 4 * n);
                    if (rb < 3) ne = *(const EPI_LAS f32x4*)(E + (((rb + 1) * 2 + 0) * 2 + ab) * 128 + cl0 + 4 * n);
                    f32x4 mir[4];
#pragma unroll
                    for (int m = 0; m < 4; ++m)
#pragma unroll
                        for (int j = 0; j < 4; ++j) mir[m][j] = dpp_upd<0x140>(0.f, acc[ai][ab][m][n][j]);
#pragma unroll
                    for (int m = 0; m < 4; ++m)
#pragma unroll
                        for (int j = 0; j < 4; ++j) { const float v = acc[ai][ab][m][n][j];
                            const float prev = dpp_upd<0x111>(m > 0 ? mir[m - 1][j] : pe[j], v);
                            const float next = dpp_upd<0x101>(m < 3 ? mir[m + 1][j] : ne[j], v);
                            z[ab][m][j] = w[ab][0][j] * prev + w[ab][1][j] * v + w[ab][2][j] * next + bs[ab][j]; }
                }
#pragma unroll
                for (int m = 0; m < 4; ++m) { int row = u.pm * BM + ai * HALF + wr * 64 + m * 16 + fr; EPI_PIN(row);
                    f32x4 gq;
#pragma unroll
                    for (int j = 0; j < 4; ++j) { const float za = z[0][m][j]; gq[j] = za * __builtin_amdgcn_rcpf(1.0f + __expf(-za)) * z[1][m][j]; }
                    u32x2 o; o.x = cvt_pk_bf16(gq[0], gq[1]); o.y = cvt_pk_bf16(gq[2], gq[3]);
                    *(u32x2*)(G + (size_t)row * DFF + c) = o; }
                if (lat) {
                    if (ai == 0 && wr == 0 && fr == 0) {
#pragma unroll
                        for (int ab = 0; ab < 2; ++ab) { *(f32x4*)(EDGE + ((size_t)(u.pm * 4 + 0) * 2 + ab) * DFF + c) = z[ab][0]; *(f32x4*)(EDGE + ((size_t)(u.pm * 4 + 2) * 2 + ab) * DFF + c) = acc[0][ab][0][n]; } }
                    if (ai == 1 && wr == 1 && fr == 15) {
#pragma unroll
                        for (int ab = 0; ab < 2; ++ab) { *(f32x4*)(EDGE + ((size_t)(u.pm * 4 + 1) * 2 + ab) * DFF + c) = z[ab][3]; *(f32x4*)(EDGE + ((size_t)(u.pm * 4 + 3) * 2 + ab) * DFF + c) = acc[1][ab][3][n]; } }
                }
                EPI_FENCE();
            }
        }
    }
};

struct EpiGateRes {
    static constexpr bool PERM = false;
    const float* base_ctx; const float* base_lat; float* out; const float* gate;
    __device__ __forceinline__ void operator()(const f32x4 (&acc)[2][2][4][2], const Unit& u, int wr, int wc, int fr, int fq, EPI_LAS float*) const {
        const int cond = (u.pm < NCTX / BM) ? 0 : 1 + (u.pm - NCTX / BM) / (LAT_T / BM);
        const int col0 = u.pn * BM + wc * 32 + 4 * fq; const float* gp = gate + (size_t)cond * (NMOD * DM) + col0;
        f32x4 gv[2][2];
#pragma unroll
        for (int bj = 0; bj < 2; ++bj)
#pragma unroll
            for (int n = 0; n < 2; ++n) gv[bj][n] = *(const f32x4*)(gp + bj * HALF + n * 16);
        const float* base = (u.pm < NCTX / BM) ? base_ctx : base_lat - (size_t)NCTX * DM;
#pragma unroll
        for (int ai = 0; ai < 2; ++ai)
#pragma unroll
            for (int m = 0; m < 4; ++m) { const size_t off = (size_t)(u.pm * BM + ai * HALF + wr * 64 + m * 16 + fr) * DM + col0;
#pragma unroll
                for (int bj = 0; bj < 2; ++bj)
#pragma unroll
                    for (int n = 0; n < 2; ++n) { const f32x4 bs = *(const f32x4*)(base + off + bj * HALF + n * 16); *(f32x4*)(out + off + bj * HALF + n * 16) = bs + gv[bj][n] * acc[ai][bj][m][n]; }
                if (m & 1) asm volatile("" ::: "memory"); }
    }
};
}
namespace att {
using bf16 = unsigned short;
constexpr int DQ = 192, DVV = 128, NW = 8, QBLK = 32, KVBLK = 64;
constexpr float SCALE = 0.07216878364870322f;
constexpr float THR = 8.f;
constexpr int LDQ = 8 * DQ, LDKK = 8 * DQ, LDVV = 8 * DVV, LDO = 2048;
constexpr int SHM_V = KVBLK * DVV * 2, SHM_K = KVBLK * DQ * 2, NQR = 6  , SHM_QR = NW * (12 - NQR) * 1024, SHM_ATTN = 2 * SHM_V + 2 * SHM_K + NW * 64 * 4 + SHM_QR;
using bf16x8 = __attribute__((ext_vector_type(8))) short;
using s16x4  = __attribute__((ext_vector_type(4))) short;
using f32x16 = __attribute__((ext_vector_type(16))) float;
using u32x4  = __attribute__((ext_vector_type(4))) unsigned;
#define KSWZ(row, colB) ((row) * 384 + ((colB) ^ ((((row) >> 1) & 7) << 4)))
#define SBAR() __builtin_amdgcn_sched_barrier(0)
__device__ __forceinline__ int crow(int r, int hi) { return (r & 3) + 8 * (r >> 2) + 4 * hi; }
__device__ __forceinline__ unsigned cvtpk(float lo, float hi) { unsigned r; asm volatile("v_cvt_pk_bf16_f32 %0, %1, %2" : "=v"(r) : "v"(lo), "v"(hi)); return r; }

__device__ __forceinline__ void partialSM(f32x16& p0, f32x16& p1, float& m_reg, float& mn, float& alpha) {
  constexpr float C = SCALE * 1.4426950408889634f;
  float pmax = p0[0];
#pragma unroll
  for (int r = 1; r < 16; ++r) pmax = fmaxf(pmax, p0[r]);
#pragma unroll
  for (int r = 0; r < 16; ++r) pmax = fmaxf(pmax, p1[r]);
  { auto rr = __builtin_amdgcn_permlane32_swap(__float_as_uint(pmax), __float_as_uint(pmax), false, false);
    pmax = fmaxf(__uint_as_float(rr[0]), __uint_as_float(rr[1])); }
  if (__builtin_expect(__all(pmax - m_reg <= THR / SCALE), 1)) { mn = m_reg; alpha = 1.f; }
  else { mn = fmaxf(m_reg, pmax); alpha = __builtin_amdgcn_exp2f((m_reg - mn) * C); m_reg = mn; }
  float mnC = -mn * C;
#pragma unroll
  for (int r = 0; r < 16; ++r) p0[r] = fmaf(p0[r], C, mnC);
#pragma unroll
  for (int r = 0; r < 16; ++r) p1[r] = fmaf(p1[r], C, mnC);
#pragma unroll
  for (int r = 0; r < 16; ++r) p0[r] = __builtin_amdgcn_exp2f(p0[r]);
}
__device__ __forceinline__ void finishSM(f32x16& p0, f32x16& p1, float alpha, float& l_reg, bf16x8& pa0, bf16x8& pa1, bf16x8& pa2, bf16x8& pa3) {
#pragma unroll
  for (int r = 0; r < 16; ++r) p1[r] = __builtin_amdgcn_exp2f(p1[r]);
  float ps = 0;
#pragma unroll
  for (int r = 0; r < 16; ++r) ps += p0[r];
#pragma unroll
  for (int r = 0; r < 16; ++r) ps += p1[r];
  { auto rr = __builtin_amdgcn_permlane32_swap(__float_as_uint(ps), __float_as_uint(ps), false, false);
    ps = __uint_as_float(rr[0]) + __uint_as_float(rr[1]); }
  l_reg = l_reg * alpha + ps;
#define PK4(P, BASE, OUT) do { unsigned a0 = cvtpk(P[BASE + 0], P[BASE + 1]), a1 = cvtpk(P[BASE + 2], P[BASE + 3]);   \
    unsigned b0 = cvtpk(P[BASE + 4], P[BASE + 5]), b1 = cvtpk(P[BASE + 6], P[BASE + 7]);                              \
    auto r0 = __builtin_amdgcn_permlane32_swap(a0, b0, false, false); auto r1 = __builtin_amdgcn_permlane32_swap(a1, b1, false, false); \
    u32x4 w = {r0[0], r1[0], r0[1], r1[1]}; OUT = *reinterpret_cast<bf16x8*>(&w); } while (0)
  PK4(p0, 0, pa0); PK4(p0, 8, pa1); PK4(p1, 0, pa2); PK4(p1, 8, pa3);
#undef PK4
}
__device__ __forceinline__ void qkt(f32x16& p0, f32x16& p1, const char* Ks, const bf16x8* qr, const char* qw, int r32, int hi) {
  p0 = f32x16{}; p1 = f32x16{};
#pragma unroll
  for (int d0 = 0; d0 < 12; ++d0) { int cb = (d0 * 16 + hi * 8) * 2;
    bf16x8 b0 = *reinterpret_cast<const bf16x8*>(Ks + KSWZ(r32, cb));
    bf16x8 b1 = *reinterpret_cast<const bf16x8*>(Ks + KSWZ(32 + r32, cb));
    const bf16x8 qf = (d0 < NQR) ? qr[d0 < NQR ? d0 : 0] : *reinterpret_cast<const bf16x8*>(qw + (d0 - NQR) * 1024);
    p0 = __builtin_amdgcn_mfma_f32_32x32x16_bf16(b0, qf, p0, 0, 0, 0);
    p1 = __builtin_amdgcn_mfma_f32_32x32x16_bf16(b1, qf, p1, 0, 0, 0); }
}
__device__ __forceinline__ int v_st(int k, int c) { const int kk = (k & ~0xC) | ((k & 4) << 1) | ((k & 8) >> 1); return ((kk >> 3) * 4 + (c >> 5)) * 512 + ((kk & 7) * 32 + (c & 31)) * 2; }
__device__ __forceinline__ int v_rd_base(int lane) { return ((lane & 3) << 3) | (((lane >> 2) & 3) << 6) | (((lane >> 4) & 1) << 5) | (((lane >> 5) & 1) << 8); }
constexpr int v_rd_off(int d0, int ks, int half) { return d0 * 512 + ks * 4096 + half * 2048; }
template <int OFF> __device__ __forceinline__ s16x4 tr_read(int vb) {
  s16x4 r; asm volatile("ds_read_b64_tr_b16 %0, %1 offset:%2" : "=&v"(r) : "v"(vb), "i"(OFF) : "memory"); return r;
}
template <int D0> __device__ __forceinline__ void pv_one(f32x16& od, int vb, bf16x8 pa0, bf16x8 pa1, bf16x8 pa2, bf16x8 pa3) {
  const s16x4 l0 = tr_read<v_rd_off(D0, 0, 0)>(vb), h0 = tr_read<v_rd_off(D0, 0, 1)>(vb), l1 = tr_read<v_rd_off(D0, 1, 0)>(vb), h1 = tr_read<v_rd_off(D0, 1, 1)>(vb);
  const s16x4 l2 = tr_read<v_rd_off(D0, 2, 0)>(vb), h2 = tr_read<v_rd_off(D0, 2, 1)>(vb), l3 = tr_read<v_rd_off(D0, 3, 0)>(vb), h3 = tr_read<v_rd_off(D0, 3, 1)>(vb);
  asm volatile("s_waitcnt lgkmcnt(0)" ::: "memory"); SBAR();
#define PK(L, H) (bf16x8){L[0], L[1], L[2], L[3], H[0], H[1], H[2], H[3]}
  od = __builtin_amdgcn_mfma_f32_32x32x16_bf16(pa0, PK(l0, h0), od, 0, 0, 0);
  od = __builtin_amdgcn_mfma_f32_32x32x16_bf16(pa1, PK(l1, h1), od, 0, 0, 0);
  od = __builtin_amdgcn_mfma_f32_32x32x16_bf16(pa2, PK(l2, h2), od, 0, 0, 0);
  od = __builtin_amdgcn_mfma_f32_32x32x16_bf16(pa3, PK(l3, h3), od, 0, 0, 0);
#undef PK
}
__device__ __forceinline__ void pv_d0(f32x16* o, int vb, bf16x8 pa0, bf16x8 pa1, bf16x8 pa2, bf16x8 pa3) {
  pv_one<0>(o[0], vb, pa0, pa1, pa2, pa3); pv_one<1>(o[1], vb, pa0, pa1, pa2, pa3); pv_one<2>(o[2], vb, pa0, pa1, pa2, pa3); pv_one<3>(o[3], vb, pa0, pa1, pa2, pa3);
}

struct Split { float* part; float* stats; unsigned* cnt; int slot; int half; };
template <bool SPLIT>
__device__ __forceinline__ void attn_dense_body(const bf16* __restrict__ Qb, const bf16* __restrict__ Kh, const bf16* __restrict__ Vh, bf16* __restrict__ Ob, int seq, char* lds, const Split sp) {
  int tid_ = threadIdx.x; asm volatile("" : "+v"(tid_));
  const int tid = tid_, wid = tid >> 6, lane = tid & 63, r32 = lane & 31, hi = lane >> 5;
  char* V_lds = lds; char* K_lds = lds + 2 * SHM_V;
  float* ws = (float*)(lds + 2 * SHM_V + 2 * SHM_K) + wid * 64; float* li_l = ws; float* al_l = ws + 32;
  float m_reg = -1e30f, l_reg = 0; f32x16 o[4] = {}; bf16x8 qr[NQR];
  char* qw = lds + 2 * SHM_V + 2 * SHM_K + NW * 64 * 4 + wid * ((12 - NQR) * 1024) + lane * 16;
  const bf16* Qw = Qb + (long)(wid * QBLK + r32) * LDQ + hi * 8;
#pragma unroll
  for (int d0 = 0; d0 < NQR; ++d0) qr[d0] = *reinterpret_cast<const bf16x8*>(Qw + d0 * 16);
#pragma unroll
  for (int d0 = NQR; d0 < 12; ++d0) *reinterpret_cast<bf16x8*>(qw + (d0 - NQR) * 1024) = *reinterpret_cast<const bf16x8*>(Qw + d0 * 16);
  const int sr = tid >> 4, sc = (tid & 15) * 8, vst0 = v_st(sr, sc), vst1 = v_st(32 + sr, sc);
  int kg[3], kl[3];
#pragma unroll
  for (int i = 0; i < 3; ++i) { const int q = tid + 512 * i, kr_ = q / 24, kc = q % 24; kg[i] = kr_ * LDKK + kc * 8; kl[i] = KSWZ(kr_, kc * 16); }
  const int vb0 = (int)(uintptr_t)V_lds + v_rd_base(lane);
  bf16x8 vs0, vs1, ks0, ks1, ks2;
#define SLOAD(k0) do { vs0 = *(const bf16x8*)(&Vh[(long)((k0) + sr) * LDVV + sc]); vs1 = *(const bf16x8*)(&Vh[(long)((k0) + 32 + sr) * LDVV + sc]); \
    ks0 = *(const bf16x8*)(&Kh[(long)(k0) * LDKK + kg[0]]); ks1 = *(const bf16x8*)(&Kh[(long)(k0) * LDKK + kg[1]]); ks2 = *(const bf16x8*)(&Kh[(long)(k0) * LDKK + kg[2]]); } while (0)
#define SWRITE(b) do { *(bf16x8*)(V_lds + (b) * SHM_V + vst0) = vs0; *(bf16x8*)(V_lds + (b) * SHM_V + vst1) = vs1; \
    *(bf16x8*)(K_lds + (b) * SHM_K + kl[0]) = ks0; *(bf16x8*)(K_lds + (b) * SHM_K + kl[1]) = ks1; *(bf16x8*)(K_lds + (b) * SHM_K + kl[2]) = ks2; } while (0)
#define RESC(a) do { if (__any((a) < 1.f)) { if (hi == 0) al_l[r32] = (a); asm volatile("s_waitcnt lgkmcnt(0)" ::: "memory"); \
    _Pragma("unroll") for (int d = 0; d < 4; ++d) _Pragma("unroll") for (int r = 0; r < 16; ++r) o[d][r] *= al_l[crow(r, hi)]; } } while (0)
  f32x16 pA0, pA1, pB0, pB1; float mnA, mnB, alA, alB; bf16x8 pa0, pa1, pa2, pa3; const int NT = seq / KVBLK;
  SLOAD(0); asm volatile("s_waitcnt vmcnt(0)" ::: "memory"); SWRITE(0); __syncthreads();
  qkt(pA0, pA1, K_lds, qr, qw, r32, hi); partialSM(pA0, pA1, m_reg, mnA, alA);
  SLOAD(KVBLK);
  asm volatile("s_waitcnt vmcnt(0)" ::: "memory"); SWRITE(1); __syncthreads();
  for (int j = 1; j + 1 < NT; j += 2) {
    SBAR(); qkt(pB0, pB1, K_lds + SHM_K, qr, qw, r32, hi);
    finishSM(pA0, pA1, alA, l_reg, pa0, pa1, pa2, pa3); SBAR();
    SLOAD((j + 1) * KVBLK); SBAR();
    pv_d0(o, vb0, pa0, pa1, pa2, pa3); partialSM(pB0, pB1, m_reg, mnB, alB);
    __syncthreads(); asm volatile("s_waitcnt vmcnt(0)" ::: "memory"); SWRITE(0);
    RESC(alB); __syncthreads();
    SBAR(); qkt(pA0, pA1, K_lds, qr, qw, r32, hi);
    finishSM(pB0, pB1, alB, l_reg, pa0, pa1, pa2, pa3); SBAR();
    SLOAD((j + 2) * KVBLK); SBAR();
    pv_d0(o, vb0 + SHM_V, pa0, pa1, pa2, pa3); partialSM(pA0, pA1, m_reg, mnA, alA);
    __syncthreads(); asm volatile("s_waitcnt vmcnt(0)" ::: "memory"); SWRITE(1);
    RESC(alA); __syncthreads();
  }
  SBAR(); qkt(pB0, pB1, K_lds + SHM_K, qr, qw, r32, hi);
  finishSM(pA0, pA1, alA, l_reg, pa0, pa1, pa2, pa3); SBAR();
  pv_d0(o, vb0, pa0, pa1, pa2, pa3); partialSM(pB0, pB1, m_reg, mnB, alB);
  __syncthreads(); RESC(alB);
  finishSM(pB0, pB1, alB, l_reg, pa0, pa1, pa2, pa3); SBAR();
  pv_d0(o, vb0 + SHM_V, pa0, pa1, pa2, pa3);
  bf16* Ow = Ob + (long)(wid * QBLK) * LDO;
  if constexpr (!SPLIT) {
    if (hi == 0) li_l[r32] = l_reg; asm volatile("s_waitcnt lgkmcnt(0)" ::: "memory");
    float rli[16];
#pragma unroll
    for (int r = 0; r < 16; ++r) rli[r] = __builtin_amdgcn_rcpf(li_l[crow(r, hi)]);
#pragma unroll
    for (int r = 0; r < 16; ++r) { const int orow = crow(r, hi);
#pragma unroll
      for (int d0 = 0; d0 < 4; ++d0) { const float v = o[d0][r] * rli[r]; Ow[(long)orow * LDO + d0 * 32 + r32] = (bf16)(cvtpk(v, v) & 0xffffu); } }
    __syncthreads();
  } else {
    typedef float f32x4_t __attribute__((ext_vector_type(4)));
    constexpr float C = SCALE * 1.4426950408889634f;
    float* pmine = sp.part + (size_t)sp.slot * 32768 + wid * 4096 + lane * 4;
#pragma unroll
    for (int d0 = 0; d0 < 4; ++d0)
#pragma unroll
      for (int rq = 0; rq < 4; ++rq) *(f32x4_t*)(pmine + (d0 * 4 + rq) * 256) = (f32x4_t){o[d0][4 * rq], o[d0][4 * rq + 1], o[d0][4 * rq + 2], o[d0][4 * rq + 3]};
    if (hi == 0) { float* st = sp.stats + ((size_t)sp.slot * 256 + wid * 32 + r32) * 2; st[0] = m_reg; st[1] = l_reg; }
    unsigned* flag = (unsigned*)(lds + SHM_ATTN);
    asm volatile("s_waitcnt vmcnt(0)" ::: "memory");
    __syncthreads();
    if (tid == 0) {
      __builtin_amdgcn_fence(__ATOMIC_RELEASE, "agent"); asm volatile("s_waitcnt vmcnt(0)" ::: "memory");
      const unsigned old = __hip_atomic_fetch_add(sp.cnt, 1u, __ATOMIC_RELAXED, __HIP_MEMORY_SCOPE_AGENT);
      if (old == 1u) { __builtin_amdgcn_fence(__ATOMIC_ACQUIRE, "agent"); asm volatile("s_waitcnt vmcnt(0)" ::: "memory"); }
      *flag = old;
    }
    __syncthreads();
    if (*flag == 1u) {
      const int pslot = sp.slot ^ 1;
      const float* st = sp.stats + ((size_t)pslot * 256 + wid * 32 + r32) * 2; const float m_p = st[0], l_p = st[1];
      const float m0 = sp.half ? m_p : m_reg, l0 = sp.half ? l_p : l_reg, m1 = sp.half ? m_reg : m_p, l1 = sp.half ? l_reg : l_p;
      const float mm = fmaxf(m0, m1), a0 = __builtin_amdgcn_exp2f((m0 - mm) * C), a1 = __builtin_amdgcn_exp2f((m1 - mm) * C);
      const float L = fmaf(a1, l1, a0 * l0), iL = 1.0f / L;
      if (hi == 0) { li_l[r32] = a0 * iL; al_l[r32] = a1 * iL; } asm volatile("s_waitcnt lgkmcnt(0)" ::: "memory");
      const float* ppar = sp.part + (size_t)pslot * 32768 + wid * 4096 + lane * 4;
#pragma unroll
      for (int rq = 0; rq < 4; ++rq) {
        f32x4_t po[4];
#pragma unroll
        for (int d0 = 0; d0 < 4; ++d0) po[d0] = *(const f32x4_t*)(ppar + (d0 * 4 + rq) * 256);
#pragma unroll
        for (int e = 0; e < 4; ++e) { const int r = 4 * rq + e, orow = crow(r, hi); const float f0 = li_l[orow], f1 = al_l[orow];
#pragma unroll
          for (int d0 = 0; d0 < 4; ++d0) { const float x0 = sp.half ? po[d0][e] : o[d0][r], x1 = sp.half ? o[d0][r] : po[d0][e];
            const float v = fmaf(x1, f1, x0 * f0); Ow[(long)orow * LDO + d0 * 32 + r32] = (bf16)(cvtpk(v, v) & 0xffffu); } }
      }
    }
    __syncthreads();
  }
#undef SLOAD
#undef SWRITE
#undef RESC
}
#undef KSWZ
#undef SBAR
}
#ifndef MK_N_LAUNCHES
#define MK_N_LAUNCHES 1
#endif
constexpr int NWAVES = 8;
constexpr int N_PHASES = 10;
#ifndef MK_DUP
#define MK_DUP 0
#endif
constexpr int N_LAUNCHES = MK_N_LAUNCHES;

constexpr size_t MiB = 1u << 20;
constexpr size_t WS_CTL = 0, CTL_ZERO_BYTES = 1 * MiB;
constexpr size_t WS_MODP = 1 * MiB;
constexpr size_t WS_MOD = WS_MODP + 640 * 1024;
constexpr size_t WS_TAB = WS_MOD + 160 * 1024;
constexpr size_t WS_SSQQ = 2 * MiB;
constexpr size_t WS_SSQK = WS_SSQQ + 64 * 1024;
constexpr size_t WS_KPW = 3 * MiB;
constexpr size_t WS_WIN = 8 * MiB;
constexpr size_t WS_WPOOL = 16 * MiB;
constexpr size_t WS_WUQ = 17 * MiB;
constexpr size_t WS_WUKV = 19 * MiB;
constexpr size_t WS_WOUT = 20 * MiB;
constexpr size_t WS_WUP = 28 * MiB;
constexpr size_t WS_WDOWN = 72 * MiB;
constexpr size_t WS_G = 190 * MiB;
constexpr size_t WS_H = 94 * MiB;
constexpr size_t WS_U = 126 * MiB;
constexpr size_t WS_PV = 142 * MiB;
constexpr size_t WS_CQ = 158 * MiB;
constexpr size_t WS_CKVN = 166 * MiB;
constexpr size_t WS_UP = 182 * MiB;
constexpr size_t WS_Q = 182 * MiB;
constexpr size_t WS_K = 206 * MiB;
constexpr size_t WS_V = 233 * MiB;
constexpr size_t WS_MIX = 251 * MiB;
constexpr size_t WS_EDGE = 182 * MiB;
constexpr size_t WS_END = 358 * MiB;
static_assert(WS_G + (size_t)NTOK * DFF * 2 <= WS_END && WS_EDGE + (size_t)32 * 4 * 2 * DFF * 4 <= WS_G && WS_CKVN + (size_t)KVROWS * KVLORA * 2 <= WS_UP && WS_MIX + (size_t)NTOK * DM * 2 <= WS_END && WS_UP + (size_t)NTOK * 2 * DFF * 2 <= WS_END, "d_ws map");
constexpr int CW_BAR = 4096;
constexpr int CW_ATT = 16384;
constexpr size_t WS_APART = 94 * MiB;
constexpr size_t WS_ASTAT = 126 * MiB;

constexpr int RING_BYTES = 131072, SX_OFF = 139264  , MISC_OFF = SX_OFF + 8192, LDS_BYTES = 151552;
static_assert(att::SHM_ATTN + 16 <= SX_OFF && MISC_OFF + 256 <= LDS_BYTES, "LDS map");

#define GAS __attribute__((address_space(1)))
#define LAS __attribute__((address_space(3)))
typedef unsigned short bf16;
typedef unsigned v4u __attribute__((ext_vector_type(4)));
typedef unsigned v2u __attribute__((ext_vector_type(2)));
typedef float f32x4 __attribute__((ext_vector_type(4)));
typedef short bf16x8 __attribute__((ext_vector_type(8)));
#define LDS_WAIT() asm volatile("s_waitcnt lgkmcnt(0)" ::: "memory")
__device__ __forceinline__ unsigned f2bf(float f) { unsigned u = __builtin_bit_cast(unsigned, f); return (u + 0x7fffu + ((u >> 16) & 1u)) >> 16; }
__device__ __forceinline__ unsigned pk2(float lo, float hi) { return f2bf(lo) | (f2bf(hi) << 16); }
__device__ __forceinline__ float bflo(unsigned w) { return __builtin_bit_cast(float, w << 16); }
__device__ __forceinline__ float bfhi(unsigned w) { return __builtin_bit_cast(float, w & 0xffff0000u); }

#define XB_TMO      128
#define XB_XCNT(j)  (256  + 64 * (j))
#define XB_XSUB(j)  (1280 + 64 * (j))
#define XB_XGEN(j)  (2304 + 64 * (j))
#define XB_TOP      3328
#define XB_TOPGEN   3392
#define XCD_BAR_WORDS 3456
#define XB_SPIN_CAP (1u << 18)
__device__ __forceinline__ unsigned xb_ld(unsigned* p)              { return __hip_atomic_load(p, __ATOMIC_RELAXED, __HIP_MEMORY_SCOPE_AGENT); }
__device__ __forceinline__ unsigned xb_add(unsigned* p, unsigned v) { return __hip_atomic_fetch_add(p, v, __ATOMIC_RELAXED, __HIP_MEMORY_SCOPE_AGENT); }
__device__ __forceinline__ unsigned xb_xcc_id() { return (unsigned)__builtin_amdgcn_s_getreg((3 << 11) | 20) & 0xFu; }
#define XB_SPIN(cond, bar) do { unsigned _sp = 0; while (cond) { __builtin_amdgcn_s_sleep(1); \
    if ((++_sp & 255u) == 0u) { if (xb_ld(&(bar)[XB_TMO])) break; if (_sp > XB_SPIN_CAP) { atomicAdd(&(bar)[XB_TMO], 1u); break; } } } } while (0)
struct XcdBarrier { unsigned* bar; unsigned x; volatile LAS unsigned* st; };
__device__ __forceinline__ XcdBarrier xcd_barrier_post(unsigned* bar, volatile LAS unsigned* st) {
    XcdBarrier b; b.bar = bar; b.x = xb_xcc_id(); b.st = st;
    if (threadIdx.x == 0) (void)xb_add(&bar[XB_XCNT(b.x)], 1u);
    return b;
}
__device__ __forceinline__ void xcd_barrier_complete(unsigned* bar, unsigned x, unsigned& nloc, unsigned& nx) {
    const unsigned G = gridDim.x * gridDim.y * gridDim.z;
    unsigned sum, cnt, mine, sp = 0u;
    for (;;) {
        sum = 0u; cnt = 0u; mine = 0u;
#pragma unroll
        for (unsigned j = 0; j < 16; ++j) { const unsigned c = xb_ld(&bar[XB_XCNT(j)]); sum += c; cnt += (c > 0u) ? 1u : 0u; mine = (j == x) ? c : mine; }
        if (sum == G) break;
        __builtin_amdgcn_s_sleep(1);
        if ((++sp & 255u) == 0u) { if (xb_ld(&bar[XB_TMO])) break; if (sp > XB_SPIN_CAP) { atomicAdd(&bar[XB_TMO], 1u); break; } }
    }
    nloc = mine > 0u ? mine : 1u; nx = cnt > 0u ? cnt : 1u;
}
__device__ __forceinline__ void xcd_barrier(const XcdBarrier& b) {
    asm volatile("s_waitcnt vmcnt(0)" ::: "memory");
    __syncthreads();
    if (threadIdx.x == 0) {
        unsigned* bar = b.bar;
        __builtin_amdgcn_s_waitcnt(0);
        unsigned nloc = b.st[0], nx = b.st[1];
        if (nloc == 0u) { xcd_barrier_complete(bar, b.x, nloc, nx); b.st[0] = nloc; b.st[1] = nx; }
        const unsigned old = xb_add(&bar[XB_XSUB(b.x)], 1u);
        const unsigned gen = old / nloc;
        if (old + 1u == (gen + 1u) * nloc) {
            __builtin_amdgcn_fence(__ATOMIC_RELEASE, "agent");
            asm volatile("s_waitcnt vmcnt(0)" ::: "memory");
            const unsigned og = xb_add(&bar[XB_TOP], 1u);
            const unsigned tg = og / nx;
            if (og + 1u == (tg + 1u) * nx) xb_add(&bar[XB_TOPGEN], 1u);
            else XB_SPIN(xb_ld(&bar[XB_TOPGEN]) == tg, bar);
            __builtin_amdgcn_fence(__ATOMIC_ACQUIRE, "agent");
            xb_add(&bar[XB_XGEN(b.x)], 1u);
            asm volatile("s_waitcnt vmcnt(0)" ::: "memory");
        } else {
            XB_SPIN(xb_ld(&bar[XB_XGEN(b.x)]) == gen, bar);
            __builtin_amdgcn_fence(__ATOMIC_ACQUIRE, "agent");
            asm volatile("s_waitcnt vmcnt(0)" ::: "memory");
        }
    }
    __syncthreads();
}

struct Args {
    const float *x_prompt, *x_sample, *cache_ckv, *cache_kpe, *c, *c_ctx, *norm1_g, *norm2_g, *w_mod, *b_mod, *w_in, *w_pool, *pool_scale, *q_a_g, *w_uq, *kv_a_g, *w_ukv,
                *q_norm_g, *k_norm_g, *w_out, *w_up, *conv_w, *conv_b, *w_down;
    float* out; unsigned char* ws; int ph_lo, ph_hi, li, pad;
};
struct Frame {
    LAS unsigned char* lds; int tid, lane, wave, G, bid;
};
__device__ __forceinline__ float wave_sum(float v) {
#pragma unroll
    for (int o = 1; o < 64; o <<= 1) v += __shfl_xor(v, o);
    return v;
}
__device__ __forceinline__ float silu_f(float v) { return v / (1.0f + __expf(-v)); }

__device__ __forceinline__ void p0_transpose_item(const float* W, int N, int K, bf16* WT, int k0, int n0, int drow, const float* kscale, LAS float* scr, int lane) {
    float v[32];
#pragma unroll
    for (int i = 0; i < 32; ++i) v[i] = W[(size_t)(k0 + 2 * i + (lane >> 5)) * N + n0 + (lane & 31)];
    if (kscale) {
#pragma unroll
        for (int i = 0; i < 32; ++i) v[i] *= kscale[k0 + 2 * i + (lane >> 5)]; }
#pragma unroll
    for (int i = 0; i < 32; ++i) scr[(2 * i + (lane >> 5)) * 33 + (lane & 31)] = v[i];
    LDS_WAIT(); asm volatile("" ::: "memory");
    const int c = lane & 7;
#pragma unroll
    for (int j = 0; j < 4; ++j) { const int n = (lane >> 3) + 8 * j; const LAS float* s = scr + (8 * c) * 33 + n;
        v4u o; o.x = pk2(s[0 * 33], s[1 * 33]); o.y = pk2(s[2 * 33], s[3 * 33]); o.z = pk2(s[4 * 33], s[5 * 33]); o.w = pk2(s[6 * 33], s[7 * 33]);
        *(GAS v4u*)(WT + (size_t)(drow + n) * K + k0 + 8 * c) = o; }
    LDS_WAIT(); asm volatile("" ::: "memory");
}
__device__ __forceinline__ void sincos_small(float x, float& s, float& c) {
    const double xd = (double)x; const double n = __builtin_rint(xd * 0.63661977236758134); const float r = (float)(xd - n * 1.5707963267948966); const int q = ((int)n) & 3;
    const float r2 = r * r;
    const float sp = r + r * r2 * (-1.6666667163e-01f + r2 * (8.3333337680e-03f + r2 * (-1.9841270114e-04f + r2 * 2.7557314297e-06f)));
    const float cp = 1.0f + r2 * (-0.5f + r2 * (4.1666667908e-02f + r2 * (-1.3888889225e-03f + r2 * (2.4801587642e-05f + r2 * -2.7557314297e-07f))));
    const float ss = (q & 1) ? cp : sp, cc = (q & 1) ? sp : cp;
    s = (q & 2) ? -ss : ss; c = ((q + 1) & 2) ? -cc : cc;
}

constexpr int CV_UP = 1, CV_DOWN = 2, CV_OUT = 4, CV_IN = 8, CV_UQ = 16, CV_UKV = 32, CV_POOL = 64;
template <int WHICH> __device__ __forceinline__ void convert_weights(const Frame& F, const Args& a, int gw, int NGW) {
    unsigned char* ws = a.ws;
    LAS float* scr = (LAS float*)(F.lds + 32768 + F.wave * 12288);
    constexpr int I_IN = 32 * 58, I_POOL = 4 * 32, I_UQ = 8 * 48, I_UKV = 4 * 64, I_OUT = 32 * 64, I_UP = 32 * 352, I_DOWN = 88 * 64;
    constexpr int N_UP = (WHICH & CV_UP) ? I_UP : 0, N_DOWN = (WHICH & CV_DOWN) ? I_DOWN : 0, N_OUT = (WHICH & CV_OUT) ? I_OUT : 0, N_IN = (WHICH & CV_IN) ? I_IN : 0,
                  N_UQ = (WHICH & CV_UQ) ? I_UQ : 0, N_UKV = (WHICH & CV_UKV) ? I_UKV : 0, N_POOL = (WHICH & CV_POOL) ? I_POOL : 0;
    constexpr int NITEMS = N_UP + N_DOWN + N_OUT + N_IN + N_UQ + N_UKV + N_POOL;
    bf16* WIN = (bf16*)(ws + WS_WIN); bf16* WPOOL = (bf16*)(ws + WS_WPOOL); bf16* WUQ = (bf16*)(ws + WS_WUQ); bf16* WUKV = (bf16*)(ws + WS_WUKV);
    bf16* WOUT = (bf16*)(ws + WS_WOUT); bf16* WUP = (bf16*)(ws + WS_WUP); bf16* WDOWN = (bf16*)(ws + WS_WDOWN);
    for (int it = gw; it < NITEMS; it += NGW) {
        int r = it;
        if (r < N_UP) { const int nb = r % 352, kb = r / 352, n0 = nb * 32; const int nn = n0 < DFF ? n0 : n0 - DFF; const int drow = (nn >> 7) * 256 + (nn & 127) + (n0 < DFF ? 0 : 128);
            p0_transpose_item(a.w_up, 2 * DFF, DM, WUP, kb * 64, n0, drow, nullptr, scr, F.lane); continue; } r -= N_UP;
        if (r < N_DOWN) { const int nb = r % 64, kb = r / 64; p0_transpose_item(a.w_down, DM, DFF, WDOWN, kb * 64, nb * 32, nb * 32, nullptr, scr, F.lane); continue; } r -= N_DOWN;
        if (r < N_OUT) { const int nb = r % 64, kb = r / 64; p0_transpose_item(a.w_out, DM, DM, WOUT, kb * 64, nb * 32, nb * 32, nullptr, scr, F.lane); continue; } r -= N_OUT;
        if (r < N_IN) { const int nb = r % 58, kb = r / 58; p0_transpose_item(a.w_in, INW, DM, WIN, kb * 64, nb * 32, nb * 32, nullptr, scr, F.lane); continue; } r -= N_IN;
        if (r < N_UQ) { const int nb = r % 48, kb = r / 48, n0 = nb * 32; const int drow = (n0 / DQK) * 256 + (n0 % DQK); p0_transpose_item(a.w_uq, NH * DQK, QLORA, WUQ, kb * 64, n0, drow, a.q_a_g, scr, F.lane); continue; } r -= N_UQ;
        if (r < N_UKV) { const int nb = r % 64, kb = r / 64; p0_transpose_item(a.w_ukv, NH * 256, KVLORA, WUKV, kb * 64, nb * 32, nb * 32, nullptr, scr, F.lane); continue; } r -= N_UKV;
        if (N_POOL) { const int g = r / 32, rr = r % 32, nb = rr % 8, kb = rr / 8; p0_transpose_item(a.w_pool + (size_t)g * 65536, 256, 256, WPOOL + (size_t)g * 65536, kb * 64, nb * 32, nb * 32, nullptr, scr, F.lane); }
    }
}

__device__ __forceinline__ void phase0(const Frame& F, const Args& a) {
    unsigned char* ws = a.ws;
    LAS float* sl = (LAS float*)F.lds;
    LAS float* red = sl + 3 * DM;
    for (int i = F.tid; i < 3 * DM; i += NWAVES * 64) { const int r = i / DM, k = i % DM; const float v = (r == 0) ? a.c_ctx[k] : a.c[(r - 1) * DM + k]; sl[i] = silu_f(v); }
    __syncthreads();
    float* MODP = (float*)(ws + WS_MODP);
    for (int task = F.bid; task < 768; task += F.G) {
        const int cb = task % 192, kq = task / 192, kbase = kq * 512 + F.wave * 64, rg = F.lane >> 4, cl = (F.lane & 15) * 4;
        f32x4 a0 = {0.f, 0.f, 0.f, 0.f}, a1 = a0, a2 = a0;
        const float* wp = a.w_mod + (size_t)(kbase + rg) * (NMOD * DM) + cb * 64 + cl;
#pragma unroll
        for (int i = 0; i < 16; ++i) { const f32x4 w = *(const f32x4*)(wp + (size_t)(4 * i) * (NMOD * DM)); const int k = kbase + 4 * i + rg;
            a0 += w * sl[k]; a1 += w * sl[DM + k]; a2 += w * sl[2 * DM + k]; }
#pragma unroll
        for (int j = 0; j < 4; ++j) { a0[j] += __shfl_xor(a0[j], 16); a0[j] += __shfl_xor(a0[j], 32); a1[j] += __shfl_xor(a1[j], 16); a1[j] += __shfl_xor(a1[j], 32); a2[j] += __shfl_xor(a2[j], 16); a2[j] += __shfl_xor(a2[j], 32); }
        if (rg == 0) { LAS float* rp = red + F.wave * 192 + cl; *(LAS f32x4*)rp = a0; *(LAS f32x4*)(rp + 64) = a1; *(LAS f32x4*)(rp + 128) = a2; }
        __syncthreads();
        if (F.tid < 192) { float s = 0.f;
#pragma unroll
            for (int w = 0; w < 8; ++w) s += red[w * 192 + F.tid];
            const int r = F.tid / 64, cc = F.tid % 64; MODP[((size_t)kq * 3 + r) * (NMOD * DM) + cb * 64 + cc] = s; }
        __syncthreads();
    }
    const int gw = F.bid * NWAVES + F.wave, NGW = F.G * NWAVES;
    convert_weights<CV_UP | CV_IN | CV_UQ | CV_UKV | CV_POOL>(F, a, gw, NGW);
    bf16* WIN = (bf16*)(ws + WS_WIN); bf16* WUQ = (bf16*)(ws + WS_WUQ);
    const int gt = F.bid * (NWAVES * 64) + F.tid, NGT = F.G * NWAVES * 64;
    const v4u z4 = {0u, 0u, 0u, 0u};
    for (int i = gt; i < 49152 + 32768; i += NGT) {
        if (i < 49152) *(GAS v4u*)(WIN + (size_t)INW * DM + (size_t)i * 8) = z4;
        else { const int j = i - 49152, h = j / 4096, q = j % 4096; *(GAS v4u*)(WUQ + ((size_t)h * 256 + 192) * QLORA + (size_t)q * 8) = z4; }
    }
    float* TAB = (float*)(ws + WS_TAB);
    for (int i = gt; i < 1024; i += NGT) { const int pos = i >> 4, fi = i & 15; const float inv = powf(10000.0f, -(float)fi / 16.0f); float s, c; sincos_small((float)pos * inv, s, c); TAB[2 * i] = c; TAB[2 * i + 1] = s; }
    bf16* CKVN = (bf16*)(ws + WS_CKVN); float* KPW = (float*)(ws + WS_KPW); float* SSQK = (float*)(ws + WS_SSQK);
    for (int i = gw; i < LAT_B * PAST; i += NGW) { const int b = i / PAST, kr = NCTX + b * KVSEG + (i % PAST);
        const f32x4 v = *(const f32x4*)(a.cache_ckv + (size_t)i * KVLORA + F.lane * 4);
        v2u o; o.x = pk2(v[0], v[1]); o.y = pk2(v[2], v[3]); *(GAS v2u*)(CKVN + (size_t)kr * KVLORA + F.lane * 4) = o;
        const float kp = a.cache_kpe[(size_t)i * ROPED + F.lane]; KPW[(size_t)kr * ROPED + F.lane] = kp * a.k_norm_g[DNOPE + F.lane];
        const float ss = wave_sum(kp * kp); if (F.lane == 0) SSQK[kr] = ss; }
}

__device__ __forceinline__ void phase_norm(const Frame& F, const Args& a, int which) {
    unsigned char* ws = a.ws; const float* MODP = (const float*)(ws + WS_MODP); float* MOD = (float*)(ws + WS_MOD);
    LAS float* TA = (LAS float*)F.lds; LAS float* TS = TA + 3 * DM;
    const float* g = which ? a.norm2_g : a.norm1_g; const int csh = which ? 3 : 0, csc = which ? 4 : 1;
    for (int i = F.tid; i < 3 * DM; i += NWAVES * 64) { const int r = i / DM, c = i % DM; float sh, sc;
        if (which == 0) { const int i0 = r * (NMOD * DM) + csh * DM + c, i1 = r * (NMOD * DM) + csc * DM + c; sh = a.b_mod[csh * DM + c]; sc = a.b_mod[csc * DM + c];
#pragma unroll
            for (int q = 0; q < 4; ++q) { sh += MODP[(size_t)q * 3 * (NMOD * DM) + i0]; sc += MODP[(size_t)q * 3 * (NMOD * DM) + i1]; } }
        else { sh = MOD[r * (NMOD * DM) + csh * DM + c]; sc = MOD[r * (NMOD * DM) + csc * DM + c]; }
        TA[i] = g[c] * (1.0f + sc); TS[i] = sh; }
    if (which == 0) { const int gt = F.bid * (NWAVES * 64) + F.tid, NGT = F.G * NWAVES * 64;
        for (int i = gt; i < 3 * NMOD * DM; i += NGT) { float s = a.b_mod[i % (NMOD * DM)];
#pragma unroll
            for (int q = 0; q < 4; ++q) s += MODP[(size_t)q * 3 * (NMOD * DM) + i];
            MOD[i] = s; } }
    __syncthreads();
    bf16* H = (bf16*)(ws + WS_H); const int gw = F.bid * NWAVES + F.wave, NGW = F.G * NWAVES;
    for (int m = gw; m < NTOK; m += NGW) {
        const float* xrow = which ? a.out + (size_t)m * DM : (m < NCTX ? a.x_prompt + (size_t)m * DM : a.x_sample + (size_t)(m - NCTX) * DM);
        const int cond = m < NCTX ? 0 : 1 + ((m - NCTX) >> 11);
        const GAS f32x4* xr = (const GAS f32x4*)xrow + F.lane;
        f32x4 v[8]; float s = 0.f;
#pragma unroll
        for (int j = 0; j < 8; ++j) { v[j] = xr[64 * j]; s += (v[j][0] * v[j][0] + v[j][1] * v[j][1]) + (v[j][2] * v[j][2] + v[j][3] * v[j][3]); }
        const float rstd = 1.0f / sqrtf(wave_sum(s) * (1.0f / DM) + EPSN);
        GAS v2u* o8 = (GAS v2u*)(H + (size_t)m * DM) + F.lane;
#pragma unroll
        for (int j = 0; j < 8; ++j) { const int c = 256 * j + 4 * F.lane; const f32x4 ta = *(const LAS f32x4*)(TA + cond * DM + c), ts = *(const LAS f32x4*)(TS + cond * DM + c);
            const f32x4 h = v[j] * rstd * ta + ts; v2u w; w.x = pk2(h[0], h[1]); w.y = pk2(h[2], h[3]); o8[64 * j] = w; }
    }
}

template <int W> __device__ __forceinline__ void poolmix_item(const bf16* PV, bf16* MIX, const float* pool_scale, int g, int rp, int lane) {
    const int row = 2 * rp + (lane >> 5), col = g * 256 + (lane & 31) * 8;
    const int T = row < NCTX ? CTX_T : LAT_T, t = row < NCTX ? (row & (CTX_T - 1)) : ((row - NCTX) & (LAT_T - 1));
    const int lo = max(t - W / 2, 0), hi = min(t - W / 2 + W - 1, T - 1);
    v4u q[W];
#pragma unroll
    for (int j = 0; j < W; ++j) { const int tt = min(max(t - W / 2 + j, 0), T - 1); q[j] = *(const GAS v4u*)(PV + (size_t)(row - t + tt) * POOLW + col); }
    float acc[8] = {0.f, 0.f, 0.f, 0.f, 0.f, 0.f, 0.f, 0.f};
#pragma unroll
    for (int j = 0; j < W; ++j) { const int tt = t - W / 2 + j; const float mk = (tt >= 0 && tt < T) ? 1.0f : 0.0f;
        acc[0] += mk * bflo(q[j].x); acc[1] += mk * bfhi(q[j].x); acc[2] += mk * bflo(q[j].y); acc[3] += mk * bfhi(q[j].y); acc[4] += mk * bflo(q[j].z); acc[5] += mk * bfhi(q[j].z); acc[6] += mk * bflo(q[j].w); acc[7] += mk * bfhi(q[j].w); }
    const v4u qc = q[W / 2];
    const float ic = 1.0f / (float)(hi - lo + 1);
    const f32x4 s0 = *(const f32x4*)(pool_scale + col), s1 = *(const f32x4*)(pool_scale + col + 4);
    v4u o; o.x = pk2((acc[0] * ic - bflo(qc.x)) * s0[0], (acc[1] * ic - bfhi(qc.x)) * s0[1]); o.y = pk2((acc[2] * ic - bflo(qc.y)) * s0[2], (acc[3] * ic - bfhi(qc.y)) * s0[3]);
    o.z = pk2((acc[4] * ic - bflo(qc.z)) * s1[0], (acc[5] * ic - bfhi(qc.z)) * s1[1]); o.w = pk2((acc[6] * ic - bflo(qc.w)) * s1[2], (acc[7] * ic - bfhi(qc.w)) * s1[3]);
    *(GAS v4u*)(MIX + (size_t)row * DM + col) = o;
}
__device__ __forceinline__ void phase_poolmix(const Frame& F, const Args& a) {
    unsigned char* ws = a.ws; const bf16* PV = (const bf16*)(ws + WS_PV); bf16* MIX = (bf16*)(ws + WS_MIX);
    const int gw = F.bid * NWAVES + F.wave, NGW = F.G * NWAVES;
    for (int it = gw; it < (NTOK / 2) * 4; it += NGW) {
        const int g = it & 3, rp = it >> 2;
        if (g == 0) poolmix_item<2>(PV, MIX, a.pool_scale, g, rp, F.lane); else if (g == 1) poolmix_item<4>(PV, MIX, a.pool_scale, g, rp, F.lane);
        else if (g == 2) poolmix_item<8>(PV, MIX, a.pool_scale, g, rp, F.lane); else poolmix_item<16>(PV, MIX, a.pool_scale, g, rp, F.lane);
    }
}

__device__ __forceinline__ void phase_convgate(const Frame& F, const Args& a) {
    unsigned char* ws = a.ws; const bf16* UP = (const bf16*)(ws + WS_UP); bf16* Gb = (bf16*)(ws + WS_G);
    const int gw = F.bid * NWAVES + F.wave, NGW = F.G * NWAVES;
    for (int it = gw; it < (NTOK / 32) * 11; it += NGW) {
        const int strip = it % 11, blk = it / 11, c0 = strip * 512 + F.lane * 8, r0 = blk * 32;
        const int ua = (c0 >> 7) * 256 + (c0 & 127);
        const int T = r0 < NCTX ? CTX_T : LAT_T, t0 = r0 < NCTX ? (r0 & (CTX_T - 1)) : ((r0 - NCTX) & (LAT_T - 1));
        float wa[3][8], wb[3][8], ba[8], bb[8];
#pragma unroll
        for (int j = 0; j < 3; ++j)
#pragma unroll
            for (int e = 0; e < 8; ++e) { wa[j][e] = a.conv_w[(size_t)j * 2 * DFF + c0 + e]; wb[j][e] = a.conv_w[(size_t)j * 2 * DFF + DFF + c0 + e]; }
#pragma unroll
        for (int e = 0; e < 8; ++e) { ba[e] = a.conv_b[c0 + e]; bb[e] = a.conv_b[DFF + c0 + e]; }
        const v4u z4 = {0u, 0u, 0u, 0u};
        v4u pa = z4, pb = z4, ca, cb;
        if (t0 > 0) { pa = *(const GAS v4u*)(UP + (size_t)(r0 - 1) * (2 * DFF) + ua); pb = *(const GAS v4u*)(UP + (size_t)(r0 - 1) * (2 * DFF) + ua + 128); }
        ca = *(const GAS v4u*)(UP + (size_t)r0 * (2 * DFF) + ua); cb = *(const GAS v4u*)(UP + (size_t)r0 * (2 * DFF) + ua + 128);
        for (int i = 0; i < 32; ++i) {
            v4u na = z4, nb = z4;
            if (t0 + i + 1 < T) { na = *(const GAS v4u*)(UP + (size_t)(r0 + i + 1) * (2 * DFF) + ua); nb = *(const GAS v4u*)(UP + (size_t)(r0 + i + 1) * (2 * DFF) + ua + 128); }
            float g[8];
#define CG(e, PA, CA, NA, PB, CB, NB) { const float za = wa[0][e] * (PA) + wa[1][e] * (CA) + wa[2][e] * (NA) + ba[e]; const float zb = wb[0][e] * (PB) + wb[1][e] * (CB) + wb[2][e] * (NB) + bb[e]; g[e] = silu_f(za) * zb; }
            CG(0, bflo(pa.x), bflo(ca.x), bflo(na.x), bflo(pb.x), bflo(cb.x), bflo(nb.x)) CG(1, bfhi(pa.x), bfhi(ca.x), bfhi(na.x), bfhi(pb.x), bfhi(cb.x), bfhi(nb.x))
            CG(2, bflo(pa.y), bflo(ca.y), bflo(na.y), bflo(pb.y), bflo(cb.y), bflo(nb.y)) CG(3, bfhi(pa.y), bfhi(ca.y), bfhi(na.y), bfhi(pb.y), bfhi(cb.y), bfhi(nb.y))
            CG(4, bflo(pa.z), bflo(ca.z), bflo(na.z), bflo(pb.z), bflo(cb.z), bflo(nb.z)) CG(5, bfhi(pa.z), bfhi(ca.z), bfhi(na.z), bfhi(pb.z), bfhi(cb.z), bfhi(nb.z))
            CG(6, bflo(pa.w), bflo(ca.w), bflo(na.w), bflo(pb.w), bflo(cb.w), bflo(nb.w)) CG(7, bfhi(pa.w), bfhi(ca.w), bfhi(na.w), bfhi(pb.w), bfhi(cb.w), bfhi(nb.w))
#undef CG
            v4u o; o.x = pk2(g[0], g[1]); o.y = pk2(g[2], g[3]); o.z = pk2(g[4], g[5]); o.w = pk2(g[6], g[7]);
            *(GAS v4u*)(Gb + (size_t)(r0 + i) * DFF + c0) = o;
            pa = ca; pb = cb; ca = na; cb = nb;
        }
    }
}

__device__ __forceinline__ void phase_convfix(const Frame& F, const Args& a) {
    unsigned char* ws = a.ws; const float* EDGE = (const float*)(ws + WS_EDGE); bf16* Gb = (bf16*)(ws + WS_G);
    const int gw = F.bid * NWAVES + F.wave, NGW = F.G * NWAVES;
    for (int it = gw; it < 14 * 22; it += NGW) {
        const int bd = it / 22, c = (it % 22) * 256 + F.lane * 4, pm = 16 + (bd / 7) * 8 + (bd % 7);
        f32x4 z1[2], z2[2];
#pragma unroll
        for (int ab = 0; ab < 2; ++ab) {
            const f32x4 zl = *(const f32x4*)(EDGE + ((size_t)(pm * 4 + 1) * 2 + ab) * DFF + c), uf = *(const f32x4*)(EDGE + ((size_t)((pm + 1) * 4 + 2) * 2 + ab) * DFF + c);
            const f32x4 zf = *(const f32x4*)(EDGE + ((size_t)((pm + 1) * 4 + 0) * 2 + ab) * DFF + c), ul = *(const f32x4*)(EDGE + ((size_t)(pm * 4 + 3) * 2 + ab) * DFF + c);
            const f32x4 w0 = *(const f32x4*)(a.conv_w + ab * DFF + c), w2 = *(const f32x4*)(a.conv_w + (size_t)2 * (2 * DFF) + ab * DFF + c);
            z1[ab] = zl + w2 * uf; z2[ab] = zf + w0 * ul; }
        v2u o1, o2; float g1[4], g2[4];
#pragma unroll
        for (int j = 0; j < 4; ++j) { g1[j] = silu_f(z1[0][j]) * z1[1][j]; g2[j] = silu_f(z2[0][j]) * z2[1][j]; }
        o1.x = pk2(g1[0], g1[1]); o1.y = pk2(g1[2], g1[3]); o2.x = pk2(g2[0], g2[1]); o2.y = pk2(g2[2], g2[3]);
        const size_t r1 = (size_t)pm * 256 + 255;
        *(GAS v2u*)(Gb + r1 * DFF + c) = o1; *(GAS v2u*)(Gb + (r1 + 1) * DFF + c) = o2;
    }
}

__global__ void __launch_bounds__(NWAVES * 64, 2) mk_fwd(Args args) {
    extern __shared__ __attribute__((aligned(16))) unsigned char lds[];
    Frame F;
    F.lds = (LAS unsigned char*)lds; F.tid = threadIdx.x; F.lane = F.tid & 63; F.wave = __builtin_amdgcn_readfirstlane(F.tid >> 6); F.G = gridDim.x; F.bid = blockIdx.x;
    volatile LAS unsigned* MISC = (volatile LAS unsigned*)(F.lds + MISC_OFF);
    unsigned char* ws = args.ws;
    for (int u = F.tid; u < 64; u += NWAVES * 64) MISC[u] = 0u;
    __syncthreads();
    XcdBarrier bar; bar.bar = (unsigned*)(ws + WS_CTL) + CW_BAR; bar.x = 0; bar.st = nullptr;
    if (N_LAUNCHES == 1) bar = xcd_barrier_post((unsigned*)(ws + WS_CTL) + CW_BAR, MISC + 8);
    const int lo = args.ph_lo, hi = args.ph_hi;
#define IN(k) (lo <= (k) && (k) < hi)
#define REP(k) for (int rep_ = 0; rep_ < 1 + ((MK_DUP >> (k)) & 1); ++rep_)
#define MK_DUP_REP rep_
#define SEAM(k) do { if (IN(k) && IN((k) + 1)) xcd_barrier(bar); } while (0)
    LAS float* sx = (LAS float*)(F.lds + SX_OFF);
    bf16* WIN = (bf16*)(ws + WS_WIN); bf16* WPOOL = (bf16*)(ws + WS_WPOOL); bf16* WUQ = (bf16*)(ws + WS_WUQ); bf16* WUKV = (bf16*)(ws + WS_WUKV);
    bf16* WOUT = (bf16*)(ws + WS_WOUT); bf16* WUP = (bf16*)(ws + WS_WUP); bf16* WDOWN = (bf16*)(ws + WS_WDOWN);
    bf16* Hb = (bf16*)(ws + WS_H); bf16* Ub = (bf16*)(ws + WS_U); bf16* PVb = (bf16*)(ws + WS_PV); bf16* CQb = (bf16*)(ws + WS_CQ); bf16* CKVN = (bf16*)(ws + WS_CKVN);
    bf16* Qb = (bf16*)(ws + WS_Q); bf16* Kb = (bf16*)(ws + WS_K); bf16* Vb = (bf16*)(ws + WS_V); bf16* MIX = (bf16*)(ws + WS_MIX); bf16* UPb = (bf16*)(ws + WS_UP); bf16* Gb = (bf16*)(ws + WS_G);
    float* MOD = (float*)(ws + WS_MOD); float* TAB = (float*)(ws + WS_TAB); float* SSQQ = (float*)(ws + WS_SSQQ); float* SSQK = (float*)(ws + WS_SSQK); float* KPW = (float*)(ws + WS_KPW);

    if (IN(0)) REP(0) { phase0(F, args); } SEAM(0);
    if (IN(1)) REP(1) { phase_norm(F, args, 0); } SEAM(1);
    if (IN(2)) REP(2) {
        pg8::Gemm g{Hb, WIN}; pg8::StaticOrder S; S.init(NTOK, 2048, F.G, F.bid);
        epi::EpiIn E{Ub, CQb, CKVN, SSQQ, SSQK, KPW, args.out + (size_t)NTOK * DM, args.out + (size_t)NTOK * DM + (size_t)NCTX * KVLORA, args.kv_a_g, args.k_norm_g, TAB};
        pg8::gemm_phase<pg8::Geo<DM, DM, DM, 0>>(F.lds, sx, g, S, E);
    } SEAM(2);
    if (IN(3)) REP(3) {
        { pg8::Gemm g{Ub, WPOOL}; pg8::StaticOrder S; S.init(NTOK, 1024, F.G, (F.bid + 128) % F.G); epi::EpiBf16<POOLW> E{PVb}; pg8::gemm_phase<pg8::Geo<POOLW, 256, 256, 512>>(F.lds, sx, g, S, E); }
        { pg8::Gemm g{CQb, WUQ}; pg8::StaticOrder S; S.init(NTOK, 2048, F.G, F.bid); epi::EpiQ E{Qb, SSQQ, args.q_norm_g, TAB}; pg8::gemm_phase<pg8::Geo<QLORA, QLORA, QLORA, 0>>(F.lds, sx, g, S, E); }
        { pg8::Gemm g{CKVN, WUKV}; pg8::StaticOrder S; S.init(KVROWS, 2048, F.G, F.bid); epi::EpiKV E{Kb, Vb, SSQK, KPW, args.k_norm_g}; pg8::gemm_phase<pg8::Geo<KVLORA, KVLORA, KVLORA, 0>>(F.lds, sx, g, S, E); }
    } SEAM(3);
    if (IN(4)) REP(4) {
        phase_poolmix(F, args);
        unsigned* actl = (unsigned*)(ws + WS_CTL) + CW_ATT;
        for (int c = F.bid; c < 256; c += F.G) {
            const int x = c & 7, j = c >> 3, bh = 2 * x + (j >> 4), b = bh >> 3, h = bh & 7, qb = (j & 15) >> 1, half = j & 1, pair = (bh * 8 + qb);
            const size_t q0 = (size_t)NCTX + (size_t)b * LAT_T + (size_t)qb * 256, k0 = (size_t)NCTX + (size_t)b * KVSEG + (size_t)half * (KVSEG / 2);
            const att::Split sp{(float*)(ws + WS_APART), (float*)(ws + WS_ASTAT), actl + 64 * pair + (MK_DUP_REP) * 64 * 128, pair * 2 + half, half};
            att::attn_dense_body<true>(Qb + q0 * (NH * DQK) + h * DQK, Kb + k0 * (NH * DQK) + h * DQK, Vb + k0 * (NH * DVH) + h * DVH, MIX + q0 * DM + POOLW + h * DVH, KVSEG / 2, (char*)lds, sp);
            if ((j & 1) == 0) { const int idx = x * 16 + (j >> 1), cb = idx >> 3, ch = idx & 7; const size_t cq0 = (size_t)cb * CTX_T; const att::Split s0{nullptr, nullptr, nullptr, 0, 0};
                att::attn_dense_body<false>(Qb + cq0 * (NH * DQK) + ch * DQK, Kb + cq0 * (NH * DQK) + ch * DQK, Vb + cq0 * (NH * DVH) + ch * DVH, MIX + cq0 * DM + POOLW + ch * DVH, CTX_T, (char*)lds, s0); }
            else if (F.G == 256) convert_weights<CV_OUT>(F, args, (x + 8 * (j >> 1)) * NWAVES + F.wave, 128 * NWAVES);
        }
        if (F.G != 256) convert_weights<CV_OUT>(F, args, F.bid * NWAVES + F.wave, F.G * NWAVES);
    } SEAM(4);
    if (IN(5)) REP(5) {
        pg8::Gemm g{MIX, WOUT}; pg8::StaticOrder S; S.init(NTOK, DM, F.G, F.bid);
        epi::EpiGateRes E{args.x_prompt, args.x_sample, args.out, MOD + 2 * DM}; pg8::gemm_phase<pg8::Geo<DM, DM, DM, 0>>(F.lds, sx, g, S, E);
    } SEAM(5);
    if (IN(6)) REP(6) { phase_norm(F, args, 1); } SEAM(6);
    if (IN(7)) REP(7) {
        pg8::Gemm g{Hb, WUP}; pg8::StaticOrder S; S.init(NTOK, 2 * DFF, F.G, F.bid); epi::EpiUpConv E{Gb, (float*)(ws + WS_EDGE), args.conv_w, args.conv_b}; pg8::gemm_phase<pg8::Geo<DM, DM, DM, 0>>(F.lds, sx, g, S, E);
        if (F.G == 256) { if (F.bid >= 128) convert_weights<CV_DOWN>(F, args, (F.bid - 128) * NWAVES + F.wave, 128 * NWAVES); }
        else convert_weights<CV_DOWN>(F, args, F.bid * NWAVES + F.wave, F.G * NWAVES);
    } SEAM(7);
    if (IN(8)) REP(8) { phase_convfix(F, args); } SEAM(8);
#if defined(MK_PROBE9)
    if (IN(9)) { pg8::Gemm g{Gb, WDOWN}; pg8::StaticOrder S; S.init(NTOK, DM, F.G, F.bid);
        epi::EpiGateRes E{args.out, args.out + (size_t)NCTX * DM, (float*)(ws + WS_UP), MOD + 5 * DM}; pg8::gemm_phase<pg8::Geo<DFF, DFF, DFF, 0>>(F.lds, sx, g, S, E); }
#endif
#if defined(MK_PROBEBAR)
    if (IN(9)) { for (int i = 0; i < 10; ++i) xcd_barrier(bar); }
#endif
    if (IN(9)) REP(9) {
        pg8::Gemm g{Gb, WDOWN}; pg8::StaticOrder S; S.init(NTOK, DM, F.G, F.bid);
        epi::EpiGateRes E{args.out, args.out + (size_t)NCTX * DM, args.out, MOD + 5 * DM}; pg8::gemm_phase<pg8::Geo<DFF, DFF, DFF, 0>>(F.lds, sx, g, S, E);
    }
#undef IN
#undef SEAM
}

extern "C" void kernel_launch(void* const* d_in, const int* in_sizes, int n_in, void* d_out, int out_size, void* d_ws, size_t ws_size, hipStream_t stream) {
    static int grid = 0;
    if (grid == 0) {
        if (n_in != 24 || in_sizes[0] != NCTX * DM || in_sizes[8] != DM * NMOD * DM || ws_size < WS_END) {
            fprintf(stderr, "kernel_launch: unexpected shapes: n_in %d in0 %d in8 %d ws %zu (need >= %zu); nothing launched\n", n_in, n_in > 0 ? in_sizes[0] : -1, n_in > 8 ? in_sizes[8] : -1, ws_size, (size_t)WS_END); grid = -1; return; }
        int dev = 0, cus = 0;
        if (hipGetDevice(&dev) != hipSuccess || hipDeviceGetAttribute(&cus, hipDeviceAttributeMultiprocessorCount, dev) != hipSuccess) { fprintf(stderr, "kernel_launch: device query failed\n"); grid = -1; return; }
        if (hipFuncSetAttribute((const void*)mk_fwd, hipFuncAttributeMaxDynamicSharedMemorySize, LDS_BYTES) != hipSuccess) { fprintf(stderr, "kernel_launch: hipFuncSetAttribute failed\n"); grid = -1; return; }
        (void)hipGetLastError();
        grid = cus;
    }
    if (grid < 0) return;
    if (hipMemsetAsync((char*)d_ws + WS_CTL, 0, CTL_ZERO_BYTES, stream) != hipSuccess) { fprintf(stderr, "kernel_launch: memset failed\n"); return; }
    Args a{};
    const float** ap = (const float**)&a;
    for (int i = 0; i < 24; ++i) ap[i] = (const float*)d_in[i];
    a.out = (float*)d_out; a.ws = (unsigned char*)d_ws;
    for (int li = 0; li < N_LAUNCHES; ++li) {
        a.ph_lo = (N_LAUNCHES == 1) ? 0 : li; a.ph_hi = (N_LAUNCHES == 1) ? N_PHASES : li + 1; a.li = li;
        hipLaunchKernelGGL(mk_fwd, dim3(grid), dim3(NWAVES * 64), LDS_BYTES, stream, a);
        const hipError_t le = hipPeekAtLastError();
        if (le != hipSuccess) { fprintf(stderr, "kernel_launch: launch %d failed: %s\n", li, hipGetErrorName(le)); break; }
    }
}
```
